# Optimizing an MI355X kernel written in HIP

```python
import math
import jax, jax.numpy as jnp
from jax import lax
import numpy as np

D_MODEL = 2048
BATCH = 2
SEQ = 16384
DEPTH = 1

MIX_WIDTH = D_MODEL
SCONV_WIDTH = MIX_WIDTH // 2
SCONV_GROUPS = 8
SCONV_K = 3
GDN_HEAD_DIM = 128
GDN_V_HEADS = (MIX_WIDTH - SCONV_WIDTH) // GDN_HEAD_DIM
GDN_K_HEADS = GDN_V_HEADS // 2
GDN_KEY_DIM = GDN_K_HEADS * GDN_HEAD_DIM
GDN_VALUE_DIM = GDN_V_HEADS * GDN_HEAD_DIM
GDN_CONV_K = 4
GDN_CHUNK = 64
GDN_CONV_DIM = 2 * GDN_KEY_DIM + GDN_VALUE_DIM
IN_PROJ_DIM = 3 * SCONV_WIDTH + GDN_CONV_DIM + GDN_VALUE_DIM + 2 * GDN_V_HEADS
N_MEM = 256
XA_HEADS = 4
XA_HEAD_DIM = D_MODEL // XA_HEADS
N_GROUPS = 8
EXPERTS_PER_GROUP = 8
N_EXPERTS = N_GROUPS * EXPERTS_PER_GROUP
EXPERT_TOP_K = 2
EXPERT_FF = 512
MOE_BLOCK = 128
DEEPNORM_ALPHA = (2 * DEPTH) ** 0.25
DEEPNORM_BETA = (8 * DEPTH) ** -0.25
LN_EPS = 1e-5
RMS_EPS = 1e-6
L2_EPS = 1e-6

kernel_name = 'hybrid_sconv_gdn_memxattn_hmoe_deepnorm'


def _layer_norm(x, g, b):
    xf = x.astype(jnp.float32)
    mu = jnp.mean(xf, axis=-1, keepdims=True)
    var = jnp.mean(jnp.square(xf - mu), axis=-1, keepdims=True)
    return ((xf - mu) * lax.rsqrt(var + LN_EPS) * g.astype(jnp.float32) + b.astype(jnp.float32)).astype(x.dtype)


def _l2norm(t):
    tf = t.astype(jnp.float32)
    return tf * lax.rsqrt(jnp.sum(tf * tf, axis=-1, keepdims=True) + L2_EPS)


def _causal_dwconv(x, w):
    K = w.shape[0]
    S = x.shape[1]
    xp = jnp.pad(x, ((0, 0), (K - 1, 0), (0, 0)))
    y = xp[:, 0:S] * w[0]
    for j in range(1, K):
        y = y + xp[:, j:j + S] * w[j]
    return y


def _chunk_gated_delta_rule(q, k, v, g, beta):
    Bn, S, H, Dk = q.shape
    Dv = v.shape[-1]
    C = GDN_CHUNK
    N = S // C

    def chunks(t):
        return jnp.swapaxes(t.reshape(Bn, N, C, H, -1), 2, 3)

    q = chunks(q) * (Dk ** -0.5)
    k = chunks(k)
    v = chunks(v)
    g = jnp.cumsum(jnp.swapaxes(g.reshape(Bn, N, C, H), 2, 3), axis=-1)
    beta = jnp.swapaxes(beta.reshape(Bn, N, C, H), 2, 3)
    causal = jnp.tril(jnp.ones((C, C), dtype=bool))
    strict = jnp.tril(jnp.ones((C, C), dtype=bool), k=-1)
    decay = jnp.exp(jnp.where(causal, g[..., :, None] - g[..., None, :], -jnp.inf))
    k_beta = k * beta[..., None]
    lower = jnp.where(strict, jnp.einsum('bnhid,bnhjd->bnhij', k_beta, k) * decay, 0.0)
    rhs = jnp.concatenate([v * beta[..., None], k_beta * jnp.exp(g)[..., None]], axis=-1)
    sol = lax.linalg.triangular_solve(lower, rhs, left_side=True, lower=True, unit_diagonal=True)
    u, w = sol[..., :Dv], sol[..., Dv:]
    attn = jnp.einsum('bnhid,bnhjd->bnhij', q, k) * decay
    q_decay = q * jnp.exp(g)[..., None]
    g_last = g[..., -1]
    k_tail = k * jnp.exp(g_last[..., None] - g)[..., None]

    def step(state, inp):
        u_c, w_c, qd_c, a_c, kt_c, gl_c = inp
        v_new = u_c - jnp.einsum('bhck,bhkv->bhcv', w_c, state)
        o_c = jnp.einsum('bhck,bhkv->bhcv', qd_c, state) + jnp.einsum('bhij,bhjv->bhiv', a_c, v_new)
        state = state * jnp.exp(gl_c)[..., None, None] + jnp.einsum('bhck,bhcv->bhkv', kt_c, v_new)
        return state, o_c

    xs = tuple(jnp.moveaxis(t, 1, 0) for t in (u, w, q_decay, attn, k_tail, g_last))
    state0 = jnp.zeros((Bn, H, Dk, Dv), jnp.float32)
    _, o = lax.scan(step, state0, xs)
    return jnp.transpose(o, (1, 0, 3, 2, 4)).reshape(Bn, S, H, Dv)


def _hybrid_mixer(h, w_in, sconv_w, gdn_conv_w, gdn_a_log, gdn_dt_bias, gdn_norm_w, w_out):
    Bn, S, _ = h.shape
    f32 = jnp.float32
    splits = np.cumsum([SCONV_WIDTH, SCONV_WIDTH, SCONV_WIDTH, GDN_CONV_DIM, GDN_VALUE_DIM, GDN_V_HEADS]).tolist()
    b_gate, c_gate, xa, qkv, z, a, b = jnp.split(h @ w_in, splits, axis=-1)
    y_a = b_gate * _causal_dwconv(c_gate * xa, sconv_w)
    qkv = jax.nn.silu(_causal_dwconv(qkv, gdn_conv_w))
    q, k, v = jnp.split(qkv, [GDN_KEY_DIM, 2 * GDN_KEY_DIM], axis=-1)
    rep = GDN_V_HEADS // GDN_K_HEADS
    q = jnp.repeat(_l2norm(q.reshape(Bn, S, GDN_K_HEADS, GDN_HEAD_DIM)), rep, axis=2)
    k = jnp.repeat(_l2norm(k.reshape(Bn, S, GDN_K_HEADS, GDN_HEAD_DIM)), rep, axis=2)
    v = v.reshape(Bn, S, GDN_V_HEADS, GDN_HEAD_DIM).astype(f32)
    beta = jax.nn.sigmoid(b.astype(f32))
    g = -jnp.exp(gdn_a_log.astype(f32)) * jax.nn.softplus(a.astype(f32) + gdn_dt_bias.astype(f32))
    o = _chunk_gated_delta_rule(q, k, v, g, beta)
    zf = z.reshape(Bn, S, GDN_V_HEADS, GDN_HEAD_DIM).astype(f32)
    o = o * lax.rsqrt(jnp.mean(o * o, axis=-1, keepdims=True) + RMS_EPS) * gdn_norm_w.astype(f32) * jax.nn.silu(zf)
    y_b = o.reshape(Bn, S, GDN_VALUE_DIM).astype(h.dtype)
    return jnp.concatenate([y_a, y_b], axis=-1) @ w_out


def _memory_cross_attention(h, mem, wq, wk, wv, wo):
    Bn, S, D = h.shape
    M = mem.shape[1]
    q = (h @ wq).reshape(Bn, S, XA_HEADS, XA_HEAD_DIM).astype(jnp.float32)
    k = (mem @ wk).reshape(Bn, M, XA_HEADS, XA_HEAD_DIM).astype(jnp.float32)
    v = (mem @ wv).reshape(Bn, M, XA_HEADS, XA_HEAD_DIM)
    s = jnp.einsum('bshd,bmhd->bhsm', q, k) * (XA_HEAD_DIM ** -0.5)
    p = jax.nn.softmax(s, axis=-1).astype(h.dtype)
    o = jnp.einsum('bhsm,bmhd->bshd', p, v).reshape(Bn, S, D)
    return o @ wo


def _hierarchical_moe(h, w_group, w_expert_router, w1, w3, w2):
    Bn, S, D = h.shape
    T = Bn * S
    K = EXPERT_TOP_K
    xf = h.reshape(T, D)
    g_logits = (xf @ w_group).astype(jnp.float32)
    g_idx = jnp.argmax(g_logits, axis=-1)
    g_prob = jnp.take_along_axis(jax.nn.softmax(g_logits, axis=-1), g_idx[:, None], axis=1)[:, 0]
    e_logits = (xf @ w_expert_router).astype(jnp.float32).reshape(T, N_GROUPS, EXPERTS_PER_GROUP)
    e_logits = jnp.take_along_axis(e_logits, g_idx[:, None, None], axis=1)[:, 0]
    top_p, top_i = lax.top_k(jax.nn.softmax(e_logits, axis=-1), K)
    gate = g_prob[:, None] * top_p / jnp.sum(top_p, axis=-1, keepdims=True)
    expert_id = g_idx[:, None] * EXPERTS_PER_GROUP + top_i
    TK = T * K
    flat_e = expert_id.reshape(-1)
    flat_tok = jnp.repeat(jnp.arange(T, dtype=jnp.int32), K)
    flat_gate = gate.reshape(-1)
    order = jnp.argsort(flat_e)
    sorted_e = flat_e[order]
    counts = jnp.bincount(flat_e, length=N_EXPERTS)
    start = jnp.cumsum(counts) - counts
    padded = (counts + MOE_BLOCK - 1) // MOE_BLOCK * MOE_BLOCK
    padded_end = jnp.cumsum(padded)
    padded_start = padded_end - padded
    dest = padded_start[sorted_e] + jnp.arange(TK, dtype=jnp.int32) - start[sorted_e]
    P = ((TK + MOE_BLOCK - 1) // MOE_BLOCK) * MOE_BLOCK + N_EXPERTS * MOE_BLOCK
    n_blocks = P // MOE_BLOCK
    slot_tok = jnp.full((P,), T, jnp.int32).at[dest].set(flat_tok[order])
    slot_gate = jnp.zeros((P,), jnp.float32).at[dest].set(flat_gate[order])
    block_start = jnp.arange(n_blocks, dtype=jnp.int32) * MOE_BLOCK
    block_expert = jnp.minimum(jnp.searchsorted(padded_end, block_start, side='right'), N_EXPERTS - 1)
    x_pad = jnp.concatenate([xf, jnp.zeros((1, D), xf.dtype)], axis=0)
    xb = x_pad[slot_tok].reshape(n_blocks, MOE_BLOCK, D)

    def expert_block(args):
        xblk, e = args
        hid = jax.nn.silu(xblk @ w1[e]) * (xblk @ w3[e])
        return hid @ w2[e]

    yb = lax.map(expert_block, (xb, block_expert))
    y = jnp.zeros((T + 1, D), h.dtype).at[slot_tok].add(yb.reshape(P, D) * slot_gate[:, None].astype(h.dtype))
    return y[:T].reshape(Bn, S, D)


def setup_inputs(seed: int = 0) -> dict:
    key = jax.random.key(seed)
    ks = jax.random.split(key, 32)
    f32 = jnp.float32
    L = DEPTH

    def nrm(k, shape, scale):
        return jax.random.normal(k, shape, f32) * scale

    x = nrm(ks[0], (BATCH, SEQ, D_MODEL), 1.0)
    mem = nrm(ks[1], (BATCH, N_MEM, D_MODEL), 1.0)
    ln0_g = 1.0 + nrm(ks[2], (D_MODEL,), 0.02)
    ln0_b = nrm(ks[3], (D_MODEL,), 0.02)
    w_in = nrm(ks[4], (L, D_MODEL, IN_PROJ_DIM), D_MODEL ** -0.5)
    sconv_w = nrm(ks[5], (L, SCONV_K, SCONV_WIDTH), SCONV_K ** -0.5)
    gdn_conv_w = nrm(ks[6], (L, GDN_CONV_K, GDN_CONV_DIM), GDN_CONV_K ** -0.5)
    gdn_a_log = jnp.log(jax.random.uniform(ks[7], (L, GDN_V_HEADS), f32, 1.0, 16.0))
    dt = jnp.exp(jax.random.uniform(ks[8], (L, GDN_V_HEADS), f32, math.log(1e-3), math.log(1e-1)))
    gdn_dt_bias = dt + jnp.log(-jnp.expm1(-dt))
    gdn_norm_w = 1.0 + nrm(ks[9], (L, GDN_HEAD_DIM), 0.02)
    w_mix_out = nrm(ks[10], (L, MIX_WIDTH, D_MODEL), MIX_WIDTH ** -0.5 * DEEPNORM_BETA)
    ln1_g = 1.0 + nrm(ks[11], (L, D_MODEL), 0.02)
    ln1_b = nrm(ks[12], (L, D_MODEL), 0.02)
    xa_wq = nrm(ks[13], (L, D_MODEL, D_MODEL), D_MODEL ** -0.5)
    xa_wk = nrm(ks[14], (L, D_MODEL, D_MODEL), D_MODEL ** -0.5)
    xa_wv = nrm(ks[15], (L, D_MODEL, D_MODEL), D_MODEL ** -0.5)
    xa_wo = nrm(ks[16], (L, D_MODEL, D_MODEL), D_MODEL ** -0.5 * DEEPNORM_BETA)
    ln2_g = 1.0 + nrm(ks[17], (L, D_MODEL), 0.02)
    ln2_b = nrm(ks[18], (L, D_MODEL), 0.02)
    w_group = nrm(ks[19], (L, D_MODEL, N_GROUPS), D_MODEL ** -0.5)
    w_expert_router = nrm(ks[20], (L, D_MODEL, N_EXPERTS), D_MODEL ** -0.5)
    w1 = nrm(ks[21], (L, N_EXPERTS, D_MODEL, EXPERT_FF), D_MODEL ** -0.5)
    w3 = nrm(ks[22], (L, N_EXPERTS, D_MODEL, EXPERT_FF), D_MODEL ** -0.5)
    w2 = nrm(ks[23], (L, N_EXPERTS, EXPERT_FF, D_MODEL), EXPERT_FF ** -0.5 * DEEPNORM_BETA)
    ln3_g = 1.0 + nrm(ks[24], (L, D_MODEL), 0.02)
    ln3_b = nrm(ks[25], (L, D_MODEL), 0.02)
    return {'x': x, 'mem': mem, 'ln0_g': ln0_g, 'ln0_b': ln0_b, 'w_in': w_in, 'sconv_w': sconv_w,
            'gdn_conv_w': gdn_conv_w, 'gdn_a_log': gdn_a_log, 'gdn_dt_bias': gdn_dt_bias,
            'gdn_norm_w': gdn_norm_w, 'w_mix_out': w_mix_out, 'ln1_g': ln1_g, 'ln1_b': ln1_b,
            'xa_wq': xa_wq, 'xa_wk': xa_wk, 'xa_wv': xa_wv, 'xa_wo': xa_wo, 'ln2_g': ln2_g,
            'ln2_b': ln2_b, 'w_group': w_group, 'w_expert_router': w_expert_router, 'w1': w1,
            'w3': w3, 'w2': w2, 'ln3_g': ln3_g, 'ln3_b': ln3_b}


def reference(x, mem, ln0_g, ln0_b, w_in, sconv_w, gdn_conv_w, gdn_a_log, gdn_dt_bias, gdn_norm_w,
              w_mix_out, ln1_g, ln1_b, xa_wq, xa_wk, xa_wv, xa_wo, ln2_g, ln2_b, w_group,
              w_expert_router, w1, w3, w2, ln3_g, ln3_b):
    h = _layer_norm(x, ln0_g, ln0_b)
    for l in range(DEPTH):
        mix = _hybrid_mixer(h, w_in[l], sconv_w[l], gdn_conv_w[l], gdn_a_log[l], gdn_dt_bias[l],
                            gdn_norm_w[l], w_mix_out[l])
        h = _layer_norm(DEEPNORM_ALPHA * h + mix, ln1_g[l], ln1_b[l])
        xat = _memory_cross_attention(h, mem, xa_wq[l], xa_wk[l], xa_wv[l], xa_wo[l])
        h = _layer_norm(DEEPNORM_ALPHA * h + xat, ln2_g[l], ln2_b[l])
        ffn = _hierarchical_moe(h, w_group[l], w_expert_router[l], w1[l], w3[l], w2[l])
        h = _layer_norm(DEEPNORM_ALPHA * h + ffn, ln3_g[l], ln3_b[l])
    return h
```

```cpp
#include <hip/hip_runtime.h>
#include <cstdio>
#include <cstdint>

#define LAS __attribute__((address_space(3)))
typedef unsigned short bf16_t;
typedef short bf16x8 __attribute__((ext_vector_type(8)));
typedef float f32x4 __attribute__((ext_vector_type(4)));
typedef float f32x2 __attribute__((ext_vector_type(2)));
typedef unsigned u32x4 __attribute__((ext_vector_type(4)));
typedef unsigned u32x2 __attribute__((ext_vector_type(2)));

constexpr int T_TOK = 32768, DM = 2048, SEQ = 16384;
constexpr int NPROJ = 6144, NIN = 6160;
constexpr int NEXP = 64, CAP = 32768;
constexpr float ALPHA = 1.189207115002721f;
constexpr int NTHR = 512;
constexpr int LDS_BYTES = 155648;
constexpr int XL_OFF = 131072;

constexpr size_t MiB = 1048576;
constexpr size_t WS_CTL = 0, CTL_BYTES = 65536, CTL_COUNTS = 16384;
constexpr size_t WS_WINT = WS_CTL + CTL_BYTES;
constexpr size_t WS_WOUTT = WS_WINT + (size_t)NPROJ * DM * 2;
constexpr size_t WS_WQT = WS_WOUTT + 8 * MiB, WS_WKT = WS_WQT + 8 * MiB, WS_WVT = WS_WKT + 8 * MiB, WS_WOT = WS_WVT + 8 * MiB;
constexpr size_t WS_W13T = WS_WOT + 8 * MiB;
constexpr size_t WS_W2T = WS_W13T + 256 * MiB;
constexpr size_t WS_REGA = WS_W2T + 128 * MiB;
constexpr size_t WS_REGB = WS_REGA + 128 * MiB;
constexpr size_t WS_REGC = WS_REGB + 384 * MiB;
constexpr size_t WS_STATS0 = WS_REGC + 128 * MiB;
constexpr size_t WS_AB = WS_STATS0 + (size_t)T_TOK * 8;
constexpr size_t WS_GG = WS_AB + (size_t)T_TOK * 64;
constexpr size_t WS_GB = WS_GG + (size_t)T_TOK * 32;
constexpr size_t WS_MEMB = WS_GB + (size_t)T_TOK * 32;
constexpr size_t WS_KX = WS_MEMB + 2 * MiB;
constexpr size_t WS_VT = WS_KX + 2 * MiB;
constexpr size_t WS_GATES = WS_VT + 2 * MiB;
constexpr size_t WS_SLOT = WS_GATES + (size_t)T_TOK * 8;
constexpr size_t WS_WRF = WS_SLOT + (size_t)NEXP * CAP * 4;
constexpr size_t WS_PART1 = WS_WRF + 655360;
constexpr size_t WS_SIN = WS_PART1 + (size_t)T_TOK * 32 * 8;
constexpr size_t WS_WQ2 = WS_SIN + 16 * MiB;
constexpr size_t WS_G13 = WS_WQ2 + 8 * MiB;
constexpr size_t WS_B13 = WS_G13 + 262144;
constexpr size_t WS_STATS2 = WS_B13 + 262144;
constexpr size_t WS_STATS1 = WS_STATS2 + (size_t)T_TOK * 8;
constexpr size_t WS_END = WS_STATS1 + (size_t)T_TOK * 8;
constexpr size_t WS_PART2 = WS_WQT;
constexpr size_t WS_S2 = WS_REGB + 256 * MiB;
constexpr size_t CTL_TRQ = 54272;
constexpr size_t CTL_GR = 53248, CTL_BR = 53760;
constexpr size_t WS_MT = WS_REGB + 128 * MiB, WS_NT = WS_REGB + 136 * MiB;
constexpr size_t CTL_GK = 36864, CTL_BK = 45056;
constexpr size_t CTL_G1 = 20480, CTL_B1 = 28672;

struct Params {
    const float *x, *mem, *ln0_g, *ln0_b, *w_in, *sconv_w, *gdn_conv_w, *a_log, *dt_bias, *norm_w, *w_out, *ln1_g, *ln1_b, *wq, *wk, *wv, *wo, *ln2_g, *ln2_b,
        *w_group, *w_router, *w1, *w3, *w2, *ln3_g, *ln3_b;
    float* out; unsigned char* ws;
};

typedef __bf16 bf16x2_t __attribute__((ext_vector_type(2)));
__device__ __forceinline__ unsigned cvt_pk_bf16(float lo, float hi) { const f32x2 v = {lo, hi}; return __builtin_bit_cast(unsigned, __builtin_convertvector(v, bf16x2_t)); }
__device__ __forceinline__ float bflo(unsigned w) { return __uint_as_float(w << 16); }
__device__ __forceinline__ float bfhi(unsigned w) { return __uint_as_float(w & 0xffff0000u); }
__device__ __forceinline__ int otid() { int t = threadIdx.x; asm volatile("" : "+v"(t)); return t; }
__device__ __forceinline__ const unsigned char* opaque_uniform(const unsigned char* p) { unsigned lo = __builtin_amdgcn_readfirstlane((unsigned)(uintptr_t)p), hi = __builtin_amdgcn_readfirstlane((unsigned)((uintptr_t)p >> 32));
    asm volatile("" : "+s"(lo), "+s"(hi)); return (const unsigned char*)(((uintptr_t)hi << 32) | lo); }
__device__ __forceinline__ float dpp_row_sum(float x) {
    x += __int_as_float(__builtin_amdgcn_mov_dpp(__float_as_int(x), 0xB1, 0xF, 0xF, true));
    x += __int_as_float(__builtin_amdgcn_mov_dpp(__float_as_int(x), 0x4E, 0xF, 0xF, true));
    x += __int_as_float(__builtin_amdgcn_mov_dpp(__float_as_int(x), 0x141, 0xF, 0xF, true));
    x += __int_as_float(__builtin_amdgcn_mov_dpp(__float_as_int(x), 0x140, 0xF, 0xF, true));
    return x; }
__device__ __forceinline__ float wave_sum(float v) { v = dpp_row_sum(v); const int b = __float_as_int(v);
    return (__int_as_float(__builtin_amdgcn_readlane(b, 0)) + __int_as_float(__builtin_amdgcn_readlane(b, 16))) + (__int_as_float(__builtin_amdgcn_readlane(b, 32)) + __int_as_float(__builtin_amdgcn_readlane(b, 48))); }
__device__ __forceinline__ float xrow_sum(float v) {
    const auto r = __builtin_amdgcn_permlane16_swap(__float_as_int(v), __float_as_int(v), false, false); const float s = __int_as_float(r[0]) + __int_as_float(r[1]);
    const auto q = __builtin_amdgcn_permlane32_swap(__float_as_int(s), __float_as_int(s), false, false); return __int_as_float(q[0]) + __int_as_float(q[1]); }
__device__ __forceinline__ float xrow_max(float v) {
    const auto r = __builtin_amdgcn_permlane16_swap(__float_as_int(v), __float_as_int(v), false, false); const float s = fmaxf(__int_as_float(r[0]), __int_as_float(r[1]));
    const auto q = __builtin_amdgcn_permlane32_swap(__float_as_int(s), __float_as_int(s), false, false); return fmaxf(__int_as_float(q[0]), __int_as_float(q[1])); }
__device__ __forceinline__ float wave_scan(float x) {
    x += __int_as_float(__builtin_amdgcn_update_dpp(0, __float_as_int(x), 0x111, 0xF, 0xF, false));
    x += __int_as_float(__builtin_amdgcn_update_dpp(0, __float_as_int(x), 0x112, 0xF, 0xF, false));
    x += __int_as_float(__builtin_amdgcn_update_dpp(0, __float_as_int(x), 0x114, 0xF, 0xF, false));
    x += __int_as_float(__builtin_amdgcn_update_dpp(0, __float_as_int(x), 0x118, 0xF, 0xF, false));
    x += __int_as_float(__builtin_amdgcn_update_dpp(0, __float_as_int(x), 0x142, 0xA, 0xF, false));
    x += __int_as_float(__builtin_amdgcn_update_dpp(0, __float_as_int(x), 0x143, 0xC, 0xF, false));
    return x; }
__device__ __forceinline__ float silu_f(float x) { return x / (1.0f + __expf(-x)); }

#define XB_TMO      128
#define XB_XCNT(j)  (256  + 64 * (j))
#define XB_XSUB(j)  (1280 + 64 * (j))
#define XB_XGEN(j)  (2304 + 64 * (j))
#define XB_TOP      3328
#define XB_TOPGEN   3392
#define XCD_BAR_WORDS 3456
#define XB_SPIN_CAP (1u << 18)

__device__ __forceinline__ unsigned xb_ld(unsigned* p)              { return __hip_atomic_load(p, __ATOMIC_RELAXED, __HIP_MEMORY_SCOPE_AGENT); }
__device__ __forceinline__ unsigned xb_add(unsigned* p, unsigned v) { return __hip_atomic_fetch_add(p, v, __ATOMIC_RELAXED, __HIP_MEMORY_SCOPE_AGENT); }
__device__ __forceinline__ unsigned xb_xcc_id() { return (unsigned)__builtin_amdgcn_s_getreg((3 << 11) | 20) & 0xFu; }
#define XB_SPIN(cond, bar) do { unsigned _sp = 0; while (cond) { __builtin_amdgcn_s_sleep(1); \
    if ((++_sp & 255u) == 0u) { if (xb_ld(&(bar)[XB_TMO])) break; if (_sp > XB_SPIN_CAP) { atomicAdd(&(bar)[XB_TMO], 1u); break; } } } } while (0)

struct XcdBarrier {
    unsigned* bar; unsigned x;
    volatile LAS unsigned* st;
};

__device__ __forceinline__ XcdBarrier xcd_barrier_post(unsigned* bar, volatile LAS unsigned* st) {
    XcdBarrier b; b.bar = bar; b.x = xb_xcc_id(); b.st = st;
    if (threadIdx.x == 0) (void)xb_add(&bar[XB_XCNT(b.x)], 1u);
    return b;
}
__device__ __forceinline__ void xcd_barrier_complete(unsigned* bar, unsigned x, unsigned& nloc, unsigned& nx) {
    const unsigned G = gridDim.x * gridDim.y * gridDim.z;
    unsigned sum, cnt, mine, sp = 0u;
    for (;;) {
        sum = 0u; cnt = 0u; mine = 0u;
#pragma unroll
        for (unsigned j = 0; j < 16; ++j) { const unsigned c = xb_ld(&bar[XB_XCNT(j)]); sum += c; cnt += (c > 0u) ? 1u : 0u; mine = (j == x) ? c : mine; }
        if (sum == G) break;
        __builtin_amdgcn_s_sleep(1);
        if ((++sp & 255u) == 0u) { if (xb_ld(&bar[XB_TMO])) break; if (sp > XB_SPIN_CAP) { atomicAdd(&bar[XB_TMO], 1u); break; } }
    }
    nloc = mine > 0u ? mine : 1u; nx = cnt > 0u ? cnt : 1u;
}

__device__ __forceinline__ void xcd_barrier(const XcdBarrier& b) {
    asm volatile("s_waitcnt vmcnt(0)" ::: "memory");
    __syncthreads();
    if (threadIdx.x == 0) {
        unsigned* bar = b.bar;
        __builtin_amdgcn_s_waitcnt(0);
        unsigned nloc = b.st[0], nx = b.st[1];
        if (nloc == 0u) { xcd_barrier_complete(bar, b.x, nloc, nx); b.st[0] = nloc; b.st[1] = nx; }
        const unsigned old = xb_add(&bar[XB_XSUB(b.x)], 1u);
        const unsigned gen = old / nloc;
        if (old + 1u == (gen + 1u) * nloc) {
            __builtin_amdgcn_fence(__ATOMIC_RELEASE, "agent");
            asm volatile("s_waitcnt vmcnt(0)" ::: "memory");
            const unsigned og = xb_add(&bar[XB_TOP], 1u);
            const unsigned tg = og / nx;
            if (og + 1u == (tg + 1u) * nx) xb_add(&bar[XB_TOPGEN], 1u);
            else XB_SPIN(xb_ld(&bar[XB_TOPGEN]) == tg, bar);
            __builtin_amdgcn_fence(__ATOMIC_ACQUIRE, "agent");
            xb_add(&bar[XB_XGEN(b.x)], 1u);
            asm volatile("s_waitcnt vmcnt(0)" ::: "memory");
        } else {
            XB_SPIN(xb_ld(&bar[XB_XGEN(b.x)]) == gen, bar);
            __builtin_amdgcn_fence(__ATOMIC_ACQUIRE, "agent");
            asm volatile("s_waitcnt vmcnt(0)" ::: "memory");
        }
    }
    __syncthreads();
}


namespace pg8 {
constexpr int BM = 256, BK = 64, HALF = 128, HTB = HALF * BK * 2, STAGE_BYTES = 8 * HTB, NXCD = 8, WGM = 4;
__host__ __device__ __forceinline__ int lds_byte(int r, int c) { const int st = (r >> 4) * 2 + (c >> 5), rr = r & 15, cc = c & 31, ob = rr * 64 + cc * 2; return st * 1024 + (ob ^ (((ob >> 9) & 1) << 5)); }
__host__ __device__ __forceinline__ void stage_rc(int b, int& R, int& C) { const int st = b / 1024, sb = b % 1024, swz = sb ^ (((sb >> 9) & 1) << 5); R = (st >> 1) * 16 + swz / 64; C = (st & 1) * 32 + (swz % 64) / 2; }
__host__ __device__ __forceinline__ int perm32(int rho) { const int n = rho >> 4, i = rho & 15; return 8 * (i >> 2) + 4 * n + (i & 3); }

struct GUnit { const char* A; const char* B; int pm, pn, x0, x1; };

typedef f32x4 Acc[2][2][4][2];

template <class Epi, class Sched, bool GATHER, bool LIGHTSKIP = false>
__device__ __forceinline__ void gemm_phase(LAS unsigned char* lds, LAS unsigned char* xl, const int lda, const int ldb, const int K, const Sched& S, const Epi& E) {
    const int tid = otid(), wid = __builtin_amdgcn_readfirstlane(tid >> 6), lane = tid & 63, wr = wid >> 2, wc = wid & 3, fr = lane & 15, fq = lane >> 4;
    const int nt = K / BK;
    int Rr[2], Cc[2]; unsigned voffA[2], voffB[2];
#pragma unroll
    for (int i = 0; i < 2; ++i) { stage_rc(tid * 16 + i * 8192, Rr[i], Cc[i]); const int Rb = Epi::PERM ? ((Rr[i] & ~31) + perm32(Rr[i] & 31)) : Rr[i];
        voffA[i] = (unsigned)(Rr[i] * lda + Cc[i]) * 2u; voffB[i] = (unsigned)(Rb * ldb + Cc[i]) * 2u; }
    unsigned vc[2][2], vn[2][2];
    const size_t kstep = (size_t)(BK * 2);
    const size_t hstepA = (size_t)HALF * lda * 2, hstepB = (size_t)HALF * ldb * 2;
    const unsigned ldsw = (unsigned)wid * 1024u;
    const int aoff = lds_byte(wr * 64 + fr, fq * 8), boff = lds_byte(wc * 32 + fr, fq * 8);
#define PG8_SA(b, h) (((b) * 2 + (h)) * HTB)
#define PG8_SB(b, h) ((4 + (b) * 2 + (h)) * HTB)
#define PG8_STAGE2(bufoff, gbase, o0, o1) do { \
        __builtin_amdgcn_global_load_lds((const unsigned*)((const char*)(gbase) + (o0)), (LAS unsigned*)(lds + (bufoff) + ldsw), 16, 0, 0); \
        __builtin_amdgcn_global_load_lds((const unsigned*)((const char*)(gbase) + (o1)), (LAS unsigned*)(lds + (bufoff) + ldsw + 8192), 16, 0, 0); } while (0)
#define PG8_STAGE_B(b, h, bp) PG8_STAGE2(PG8_SB(b, h), (bp) + (h) * hstepB, voffB[0], voffB[1])
#define PG8_STAGE_A(b, h, ap, NX) do { if constexpr (GATHER) { const unsigned _o0 = (NX) ? vn[h][0] : vc[h][0], _o1 = (NX) ? vn[h][1] : vc[h][1]; PG8_STAGE2(PG8_SA(b, h), (ap), _o0, _o1); } \
        else { PG8_STAGE2(PG8_SA(b, h), (ap) + (h) * hstepA, voffA[0], voffA[1]); } } while (0)
#define PG8_LDA(dst, b, h) do { _Pragma("unroll") for (int m = 0; m < 4; ++m) _Pragma("unroll") for (int k = 0; k < 2; ++k) dst[m][k] = *(const LAS bf16x8*)(lds + PG8_SA(b, h) + aoff + m * 2048 + k * 1024); } while (0)
#define PG8_LDB(dst, b, h) do { _Pragma("unroll") for (int n = 0; n < 2; ++n) _Pragma("unroll") for (int k = 0; k < 2; ++k) dst[n][k] = *(const LAS bf16x8*)(lds + PG8_SB(b, h) + boff + n * 2048 + k * 1024); } while (0)
#define PG8_MMA(ai, bj, At, Bt) do { __builtin_amdgcn_s_setprio(1); _Pragma("unroll") for (int m = 0; m < 4; ++m) _Pragma("unroll") for (int n = 0; n < 2; ++n) _Pragma("unroll") for (int k = 0; k < 2; ++k) \
        acc[ai][bj][m][n] = __builtin_amdgcn_mfma_f32_16x16x32_bf16(Bt[n][k], At[m][k], acc[ai][bj][m][n], 0, 0, 0); __builtin_amdgcn_s_setprio(0); } while (0)
#define PG8_WAIT_V(n) asm volatile("s_waitcnt vmcnt(" #n ")" ::: "memory")
#define PG8_WAIT_L(n) asm volatile("s_waitcnt lgkmcnt(" #n ")" ::: "memory")
#define PG8_BAR __builtin_amdgcn_s_barrier()
#define PG8_SCHED __builtin_amdgcn_sched_barrier(0)
    GUnit cur, nxt; int ui = 0;
    if (!S.next(0, cur)) return;
    Acc acc;
#pragma unroll
    for (int a = 0; a < 2; ++a)
#pragma unroll
        for (int b = 0; b < 2; ++b)
#pragma unroll
            for (int m = 0; m < 4; ++m)
#pragma unroll
                for (int n = 0; n < 2; ++n) acc[a][b][m][n] = (f32x4){0.f, 0.f, 0.f, 0.f};
    bf16x8 At[4][2], B0[2][2], B1[2][2];
    const char* cA = cur.A; const char* cB = cur.B;
    if constexpr (GATHER) { S.offsets(cur, lda, vc);
#pragma unroll
        for (int h = 0; h < 2; ++h) { vn[h][0] = vc[h][0]; vn[h][1] = vc[h][1]; } }
    PG8_STAGE_B(0, 0, cB); PG8_STAGE_B(0, 1, cB); PG8_STAGE_A(0, 0, cA, false); PG8_STAGE_A(0, 1, cA, false);
    if (wr == 1) PG8_BAR;
    PG8_WAIT_V(2); PG8_BAR;
    PG8_STAGE_B(1, 0, cB + kstep); PG8_STAGE_A(1, 0, cA + kstep, false); PG8_STAGE_B(1, 1, cB + kstep);
    PG8_WAIT_V(6); PG8_BAR;
    for (;;) {
        const bool has_next = S.next(ui + 1, nxt);
        const char* nA = has_next ? nxt.A : cA; const char* nB = has_next ? nxt.B : cB;
        const bool light = LIGHTSKIP && ((cur.x1 >> 16) != 0);
#pragma unroll 1
        for (int t = 0; t < nt; t += 2) {
            const bool last = (t == nt - 2);
            const char* a1 = cA + (size_t)(t + 1) * kstep;
            const char* a2 = last ? nA : cA + (size_t)(t + 2) * kstep; const char* b2 = last ? nB : cB + (size_t)(t + 2) * kstep;
            const char* a3 = a2 + kstep; const char* b3 = b2 + kstep;
            if constexpr (GATHER) { if (last && has_next) S.offsets(nxt, lda, vn); }
            PG8_LDB(B0, 0, 0); PG8_LDB(B1, 0, 1); PG8_SCHED; PG8_LDA(At, 0, 0); PG8_STAGE_A(1, 1, a1, false);
            PG8_WAIT_V(8); PG8_WAIT_L(0); PG8_BAR; PG8_MMA(0, 0, At, B0); PG8_MMA(0, 1, At, B1); PG8_BAR; PG8_SCHED;
            PG8_LDA(At, 0, 1); PG8_STAGE_B(0, 0, b2); PG8_STAGE_B(0, 1, b2); PG8_STAGE_A(0, 0, a2, last);
            PG8_WAIT_V(8); PG8_WAIT_L(0); PG8_BAR; if (!light) { PG8_MMA(1, 0, At, B0); PG8_MMA(1, 1, At, B1); } PG8_BAR; PG8_SCHED;
            PG8_LDB(B0, 1, 0); PG8_LDB(B1, 1, 1); PG8_SCHED; PG8_LDA(At, 1, 0); PG8_STAGE_A(0, 1, a2, last);
            PG8_WAIT_V(8); PG8_WAIT_L(0); PG8_BAR; PG8_MMA(0, 0, At, B0); PG8_MMA(0, 1, At, B1); PG8_BAR; PG8_SCHED;
            PG8_LDA(At, 1, 1); PG8_STAGE_B(1, 0, b3); PG8_STAGE_B(1, 1, b3); PG8_STAGE_A(1, 0, a3, last);
            PG8_WAIT_V(8); PG8_WAIT_L(0); PG8_BAR; if (!light) { PG8_MMA(1, 0, At, B0); PG8_MMA(1, 1, At, B1); } PG8_BAR; PG8_SCHED;
        }
        if (wr == 0) PG8_BAR;
        E(acc, cur, wr, wc, fr, fq, xl, wid, lane);
        if (!has_next) break;
#pragma unroll
        for (int a = 0; a < 2; ++a)
#pragma unroll
            for (int b = 0; b < 2; ++b)
#pragma unroll
                for (int m = 0; m < 4; ++m)
#pragma unroll
                    for (int n = 0; n < 2; ++n) acc[a][b][m][n] = (f32x4){0.f, 0.f, 0.f, 0.f};
        cur = nxt; cA = nA; cB = nB; ++ui;
        if constexpr (GATHER) {
#pragma unroll
            for (int h = 0; h < 2; ++h) { vc[h][0] = vn[h][0]; vc[h][1] = vn[h][1]; } }
        if (wr == 1) PG8_BAR;
    }
    PG8_WAIT_V(0);
    PG8_BAR;
#undef PG8_SA
#undef PG8_SB
#undef PG8_STAGE2
#undef PG8_STAGE_A
#undef PG8_STAGE_B
#undef PG8_LDA
#undef PG8_LDB
#undef PG8_MMA
#undef PG8_WAIT_V
#undef PG8_WAIT_L
#undef PG8_BAR
#undef PG8_SCHED
}

struct PlainSched {
    const char* A; const char* B; int nM, nN, nwg, G, c; size_t tA, tB;
    __device__ __forceinline__ void init(const void* A_, const void* B_, int M, int N, int lda, int ldb, int G_, int c_) { A = (const char*)A_; B = (const char*)B_; nM = M / BM; nN = N / BM; nwg = nM * nN; G = G_; c = c_;
        tA = (size_t)BM * lda * 2; tB = (size_t)BM * ldb * 2; }
    __device__ __forceinline__ bool next(int i, GUnit& u) const {
        const long L = (long)i * G + c; if (L >= nwg) return false;
        int wgid = (int)L; { const int q = nwg / NXCD, r = nwg % NXCD, xcd = wgid % NXCD, off = wgid / NXCD; wgid = (xcd < r ? xcd * (q + 1) : r * (q + 1) + (xcd - r) * q) + off; }
        const int nig = WGM * nN, gid = wgid / nig, fm = gid * WGM, gsz = (nM - fm) < WGM ? (nM - fm) : WGM;
        u.pm = fm + ((wgid % nig) % gsz); u.pn = (wgid % nig) / gsz; u.A = A + (size_t)u.pm * tA; u.B = B + (size_t)u.pn * tB; u.x0 = u.pm * BM; u.x1 = u.pn * BM; return true;
    }
};
struct MNSched {
    const char* kx; const char* vx; const char* wq2; const char* woT; int c, which;
    __device__ __forceinline__ bool next(int i, GUnit& u) const {
        if (i > 0 || c >= 128 || (c >= 64) != (which != 0)) return false;
        const int L = c & 63, b = L >> 5, h = (L >> 3) & 3, t8 = L & 7;
        if (c < 64) { u.A = kx + ((size_t)(b * 256) * 2048 + h * 512) * 2; u.B = wq2 + ((size_t)(t8 * 256) * 2048 + h * 512) * 2; u.x0 = b * 1024 + h * 256; u.x1 = t8 * 256; u.pm = 0; u.pn = 0; }
        else { u.A = woT + ((size_t)(t8 * 256) * 2048 + h * 512) * 2; u.B = vx + ((size_t)(b * 256) * 2048 + h * 512) * 2; u.x0 = b * 2048 + t8 * 256; u.x1 = h * 256; u.pm = 1; u.pn = 0; }
        return true;
    }
};
struct AttnS2Sched {
    const char* S1; const char* MT; int G, c;
    __device__ __forceinline__ bool next(int i, GUnit& u) const {
        const int L = i * G + c; if (L >= 512) return false;
        const int pm = L >> 2, h = L & 3, b = pm >> 6;
        u.pm = pm; u.pn = h; u.A = S1 + (size_t)pm * 256 * 2048 * 2; u.B = MT + ((size_t)(b * 1024 + h * 256) * 2048) * 2; u.x0 = pm * 256; u.x1 = h * 256; return true;
    }
};
struct AttnO2Sched {
    const char* P; const char* NT; int nwg, G, c;
    __device__ __forceinline__ bool next(int i, GUnit& u) const {
        const long L = (long)i * G + c; if (L >= 1024) return false;
        int wgid = (int)L; { const int q = 1024 / NXCD, xcd = wgid % NXCD, off = wgid / NXCD; wgid = xcd * q + off; }
        const int nig = WGM * 8, gid = wgid / nig, fm = gid * WGM;
        u.pm = fm + ((wgid % nig) % WGM); u.pn = (wgid % nig) / WGM; const int b = u.pm >> 6;
        u.A = P + (size_t)u.pm * 256 * 1024 * 2; u.B = NT + ((size_t)(b * 2048 + u.pn * 256) * 1024) * 2; u.x0 = u.pm * BM; u.x1 = u.pn * BM; return true;
    }
};
struct AttnSSched {
    const char* Q; const char* Kx; int G, c;
    __device__ __forceinline__ bool next(int i, GUnit& u) const {
        const int L = i * G + c; if (L >= 512) return false;
        const int pm = L >> 2, h = L & 3, b = pm >> 6;
        u.pm = pm; u.pn = h; u.A = Q + ((size_t)pm * 256 * 2048 + h * 512) * 2; u.B = Kx + ((size_t)b * 256 * 2048 + h * 512) * 2; u.x0 = pm * 256; u.x1 = h * 256; return true;
    }
};
struct AttnPVSched {
    const char* P; const char* Vt; int G, c;
    __device__ __forceinline__ bool next(int i, GUnit& u) const {
        const int L = i * G + c; if (L >= 1024) return false;
        const int pm = L >> 3, h = (L >> 1) & 3, pn = L & 1, b = pm >> 6;
        u.pm = pm; u.pn = pn; u.A = P + ((size_t)pm * 256 * 1024 + h * 256) * 2; u.B = Vt + ((size_t)(h * 512 + pn * 256) * 512 + b * 256) * 2; u.x0 = pm * 256; u.x1 = h * 512 + pn * 256; return true;
    }
};
struct MoeSched {
    const LAS int* ct; const LAS int* cnt; int npn, G, c; int second;
    const unsigned char* ws; const LAS int* tl;
    __device__ __forceinline__ bool next(int i, GUnit& u) const {
        const int r = c >> 3, W = G >> 3, idx = i * W + r, ti = idx / npn, pn = idx - ti * npn;
        if (ti >= __builtin_amdgcn_readfirstlane(tl[-1])) return false;
        const int ent = __builtin_amdgcn_readfirstlane(tl[ti]), e = ent & 0xff, j = (ent >> 8) & 0xff, light = ent >> 16;
        const int tau = __builtin_amdgcn_readfirstlane(ct[e]) + j;
        u.pm = e; u.pn = pn; u.x0 = tau; u.x1 = j | (light << 16);
        const char* w = (const char*)opaque_uniform(ws);
        if (!second) { u.A = w + WS_S2; u.B = w + WS_W13T + ((size_t)(e * 1024 + pn * 256) * 2048) * 2; }
        else { u.A = w + WS_REGA + ((size_t)tau * 256 * 512) * 2; u.B = w + WS_W2T + ((size_t)(e * 2048 + pn * 256) * 512) * 2; }
        return true;
    }
    __device__ __forceinline__ void offsets(const GUnit& u, int lda, unsigned (&vo)[2][2]) const {
        const int tid = otid(); int R[2], C[2];
#pragma unroll
        for (int i = 0; i < 2; ++i) stage_rc(tid * 16 + i * 8192, R[i], C[i]);
        const int e = u.pm, j = u.x1 & 0xffff, n = cnt[e]; const int* slot = (const int*)(opaque_uniform(ws) + WS_SLOT);
#pragma unroll
        for (int h = 0; h < 2; ++h)
#pragma unroll
            for (int i = 0; i < 2; ++i) { const int idx = j * 256 + h * 128 + R[i]; int tok = 0; if (idx < n) tok = slot[(size_t)e * CAP + idx] >> 1;
                vo[h][i] = (unsigned)(tok * lda + C[i]) * 2u; }
    }
};

struct EpiF32 {
    static constexpr bool PERM = false;
    float* C; int ldc;
    __device__ __forceinline__ void operator()(Acc& acc, const GUnit& u, int wr, int wc, int fr, int fq, LAS unsigned char*, int, int) const {
        const int row0 = u.x0 + wr * 64 + fr, col0 = u.x1 + wc * 32 + 4 * fq;
#pragma unroll
        for (int ai = 0; ai < 2; ++ai)
#pragma unroll
            for (int m = 0; m < 4; ++m) { float* rowp = C + (size_t)(row0 + ai * HALF + m * 16) * ldc + col0;
#pragma unroll
                for (int bj = 0; bj < 2; ++bj)
#pragma unroll
                    for (int n = 0; n < 2; ++n) *(f32x4*)(rowp + bj * HALF + n * 16) = acc[ai][bj][m][n]; }
    }
};
template <bool NT> struct EpiBf16T {
    static constexpr bool PERM = true;
    bf16_t* O; int ldc;
    __device__ __forceinline__ void operator()(Acc& acc, const GUnit& u, int wr, int wc, int fr, int fq, LAS unsigned char*, int, int) const {
        const int row0 = u.x0 + wr * 64 + fr, col0 = u.x1 + wc * 32 + 8 * fq;
#pragma unroll
        for (int ai = 0; ai < 2; ++ai)
#pragma unroll
            for (int m = 0; m < 4; ++m) { bf16_t* rowp = O + (size_t)(row0 + ai * HALF + m * 16) * ldc + col0;
#pragma unroll
                for (int bj = 0; bj < 2; ++bj) { const f32x4 v0 = acc[ai][bj][m][0], v1 = acc[ai][bj][m][1];
                    u32x4 w; w.x = cvt_pk_bf16(v0[0], v0[1]); w.y = cvt_pk_bf16(v0[2], v0[3]); w.z = cvt_pk_bf16(v1[0], v1[1]); w.w = cvt_pk_bf16(v1[2], v1[3]);
                    if constexpr (NT) __builtin_nontemporal_store(w, (u32x4*)(rowp + bj * HALF)); else *(u32x4*)(rowp + bj * HALF) = w; } }
    }
};
typedef EpiBf16T<false> EpiBf16;

struct EpiResid1 {
    static constexpr bool PERM = true;
    bf16_t* S; const bf16_t* h0b; float* part;
    __device__ __forceinline__ void operator()(Acc& acc, const GUnit& u, int wr, int wc, int fr, int fq, LAS unsigned char*, int, int) const {
        const int row0 = u.x0 + wr * 64 + fr, col0 = u.x1 + wc * 32 + 8 * fq;
#pragma unroll
        for (int ai = 0; ai < 2; ++ai)
#pragma unroll
            for (int m = 0; m < 4; ++m) { const int row = row0 + ai * HALF + m * 16; float ps = 0.f, pq = 0.f;
#pragma unroll
                for (int bj = 0; bj < 2; ++bj) { const size_t o = (size_t)row * DM + col0 + bj * HALF; const u32x4 hw = *(const u32x4*)(h0b + o);
                    const f32x4 s0 = (f32x4){bflo(hw.x), bfhi(hw.x), bflo(hw.y), bfhi(hw.y)} * ALPHA + acc[ai][bj][m][0], s1 = (f32x4){bflo(hw.z), bfhi(hw.z), bflo(hw.w), bfhi(hw.w)} * ALPHA + acc[ai][bj][m][1];
                    ps += ((s0[0] + s0[1]) + (s0[2] + s0[3])) + ((s1[0] + s1[1]) + (s1[2] + s1[3]));
                    pq += ((s0[0] * s0[0] + s0[1] * s0[1]) + (s0[2] * s0[2] + s0[3] * s0[3])) + ((s1[0] * s1[0] + s1[1] * s1[1]) + (s1[2] * s1[2] + s1[3] * s1[3]));
                    u32x4 w; w.x = cvt_pk_bf16(s0[0], s0[1]); w.y = cvt_pk_bf16(s0[2], s0[3]); w.z = cvt_pk_bf16(s1[0], s1[1]); w.w = cvt_pk_bf16(s1[2], s1[3]); *(u32x4*)(S + o) = w; }
                ps = xrow_sum(ps); pq = xrow_sum(pq);
                if (fq == 0) *(f32x2*)(part + ((size_t)row * 32 + u.pn * 4 + wc) * 2) = (f32x2){ps, pq}; }
    }
};
__device__ __forceinline__ void panel_stats_from_parts(const float* part, int rowbase, LAS unsigned char* xl, int tid, float* gout = nullptr) {
    LAS f32x2* tab = (LAS f32x2*)xl;
    if (tid < 256) { const float* pr = part + (size_t)(rowbase + tid) * 64; float s = 0.f, q = 0.f;
#pragma unroll
        for (int i = 0; i < 16; ++i) { const f32x4 v = *(const f32x4*)(pr + 4 * i); s += v[0] + v[2]; q += v[1] + v[3]; }
        const float mean = s * (1.0f / DM), var = fmaxf(q * (1.0f / DM) - mean * mean, 0.f);
        const f32x2 mr = (f32x2){mean, rsqrtf(var + 1e-5f)}; tab[tid] = mr; if (gout) *(f32x2*)(gout + (size_t)(rowbase + tid) * 2) = mr; }
    asm volatile("s_waitcnt lgkmcnt(0)" ::: "memory"); __builtin_amdgcn_s_barrier(); asm volatile("" ::: "memory");
}
struct EpiResid2 {
    static constexpr bool PERM = true;
    bf16_t* S2; const bf16_t* S1; const float* stats1; float* part2; const float* g1; const float* b1;
    __device__ __forceinline__ void operator()(Acc& acc, const GUnit& u, int wr, int wc, int fr, int fq, LAS unsigned char*, int, int) const {
        const int row0 = u.x0 + wr * 64 + fr, col0 = u.x1 + wc * 32 + 8 * fq;
        f32x4 Gv[2][2], Bv[2][2];
#pragma unroll
        for (int bj = 0; bj < 2; ++bj)
#pragma unroll
            for (int n = 0; n < 2; ++n) { Gv[bj][n] = *(const f32x4*)(g1 + col0 + bj * HALF + 4 * n) * ALPHA; Bv[bj][n] = *(const f32x4*)(b1 + col0 + bj * HALF + 4 * n) * ALPHA; }
#pragma unroll
        for (int ai = 0; ai < 2; ++ai)
#pragma unroll
            for (int m = 0; m < 4; ++m) { const int row = row0 + ai * HALF + m * 16; const f32x2 st = *(const f32x2*)(stats1 + (size_t)row * 2); float ps = 0.f, pq = 0.f;
#pragma unroll
                for (int bj = 0; bj < 2; ++bj) { const size_t o = (size_t)row * DM + col0 + bj * HALF; const u32x4 hw = *(const u32x4*)(S1 + o);
                    const f32x4 s0 = (((f32x4){bflo(hw.x), bfhi(hw.x), bflo(hw.y), bfhi(hw.y)} - st.x) * st.y) * Gv[bj][0] + Bv[bj][0] + acc[ai][bj][m][0];
                    const f32x4 s1 = (((f32x4){bflo(hw.z), bfhi(hw.z), bflo(hw.w), bfhi(hw.w)} - st.x) * st.y) * Gv[bj][1] + Bv[bj][1] + acc[ai][bj][m][1];
                    ps += ((s0[0] + s0[1]) + (s0[2] + s0[3])) + ((s1[0] + s1[1]) + (s1[2] + s1[3]));
                    pq += ((s0[0] * s0[0] + s0[1] * s0[1]) + (s0[2] * s0[2] + s0[3] * s0[3])) + ((s1[0] * s1[0] + s1[1] * s1[1]) + (s1[2] * s1[2] + s1[3] * s1[3]));
                    u32x4 w; w.x = cvt_pk_bf16(s0[0], s0[1]); w.y = cvt_pk_bf16(s0[2], s0[3]); w.z = cvt_pk_bf16(s1[0], s1[1]); w.w = cvt_pk_bf16(s1[2], s1[3]); *(u32x4*)(S2 + o) = w; }
                ps = xrow_sum(ps); pq = xrow_sum(pq);
                if (fq == 0) *(f32x2*)(part2 + ((size_t)row * 32 + u.pn * 4 + wc) * 2) = (f32x2){ps, pq}; }
    }
};
struct EpiAffineBf16 {
    static constexpr bool PERM = true;
    bf16_t* O; int ldc; const float* part; const float* G; const float* B;
    __device__ __forceinline__ void operator()(Acc& acc, const GUnit& u, int wr, int wc, int fr, int fq, LAS unsigned char* xl, int wid, int lane) const {
        panel_stats_from_parts(part, u.x0, xl, wid * 64 + lane);
        const LAS f32x2* tab = (const LAS f32x2*)xl;
        const int row0 = u.x0 + wr * 64 + fr, col0 = u.x1 + wc * 32 + 8 * fq;
        f32x4 Gv[2][2], Bv[2][2];
#pragma unroll
        for (int bj = 0; bj < 2; ++bj)
#pragma unroll
            for (int n = 0; n < 2; ++n) { Gv[bj][n] = *(const f32x4*)(G + col0 + bj * HALF + 4 * n); Bv[bj][n] = *(const f32x4*)(B + col0 + bj * HALF + 4 * n); }
#pragma unroll
        for (int ai = 0; ai < 2; ++ai)
#pragma unroll
            for (int m = 0; m < 4; ++m) { const int rl = ai * HALF + wr * 64 + m * 16 + fr; const f32x2 st = tab[rl];
                bf16_t* rowp = O + (size_t)(row0 + ai * HALF + m * 16) * ldc + col0;
#pragma unroll
                for (int bj = 0; bj < 2; ++bj) { const f32x4 v0 = (acc[ai][bj][m][0] - Gv[bj][0] * st.x) * st.y + Bv[bj][0], v1 = (acc[ai][bj][m][1] - Gv[bj][1] * st.x) * st.y + Bv[bj][1];
                    u32x4 w; w.x = cvt_pk_bf16(v0[0], v0[1]); w.y = cvt_pk_bf16(v0[2], v0[3]); w.z = cvt_pk_bf16(v1[0], v1[1]); w.w = cvt_pk_bf16(v1[2], v1[3]);
                    *(u32x4*)(rowp + bj * HALF) = w; } }
        asm volatile("s_waitcnt lgkmcnt(0)" ::: "memory"); __builtin_amdgcn_s_barrier(); asm volatile("" ::: "memory");
    }
};
struct EpiSoftmax {
    static constexpr bool PERM = true;
    bf16_t* P; float c2;
    __device__ __forceinline__ void operator()(Acc& acc, const GUnit& u, int wr, int wc, int fr, int fq, LAS unsigned char* xl, int, int) const {
        LAS f32x2* tab = (LAS f32x2*)xl;
        float mloc[2][4];
#pragma unroll
        for (int ai = 0; ai < 2; ++ai)
#pragma unroll
            for (int m = 0; m < 4; ++m) {
                float mx = -3.0e38f;
#pragma unroll
                for (int bj = 0; bj < 2; ++bj)
#pragma unroll
                    for (int n = 0; n < 2; ++n) { const f32x4 v = acc[ai][bj][m][n]; mx = fmaxf(mx, fmaxf(fmaxf(v[0], v[1]), fmaxf(v[2], v[3]))); }
                mx = xrow_max(mx);
                float s = 0.f;
#pragma unroll
                for (int bj = 0; bj < 2; ++bj)
#pragma unroll
                    for (int n = 0; n < 2; ++n) { f32x4 v = acc[ai][bj][m][n];
#pragma unroll
                        for (int j = 0; j < 4; ++j) { v[j] = __builtin_amdgcn_exp2f((v[j] - mx) * c2); s += v[j]; }
                        acc[ai][bj][m][n] = v; }
                s = xrow_sum(s);
                mloc[ai][m] = mx;
                if (fq == 0) tab[(ai * HALF + wr * 64 + m * 16 + fr) * 4 + wc] = (f32x2){mx, s};
            }
        asm volatile("s_waitcnt lgkmcnt(0)" ::: "memory"); __builtin_amdgcn_s_barrier(); asm volatile("" ::: "memory");
        const int row0 = u.x0 + wr * 64 + fr, col0 = u.x1 + wc * 32 + 8 * fq;
#pragma unroll
        for (int ai = 0; ai < 2; ++ai)
#pragma unroll
            for (int m = 0; m < 4; ++m) {
                const int r = ai * HALF + wr * 64 + m * 16 + fr;
                const f32x2 t0 = tab[r * 4 + 0], t1 = tab[r * 4 + 1], t2 = tab[r * 4 + 2], t3 = tab[r * 4 + 3];
                const float M = fmaxf(fmaxf(t0.x, t1.x), fmaxf(t2.x, t3.x));
                const float tot = t0.y * __builtin_amdgcn_exp2f((t0.x - M) * c2) + t1.y * __builtin_amdgcn_exp2f((t1.x - M) * c2) + t2.y * __builtin_amdgcn_exp2f((t2.x - M) * c2) + t3.y * __builtin_amdgcn_exp2f((t3.x - M) * c2);
                const float f = __builtin_amdgcn_exp2f((mloc[ai][m] - M) * c2) / tot;
                bf16_t* rowp = P + (size_t)(row0 + ai * HALF + m * 16) * 1024 + col0;
#pragma unroll
                for (int bj = 0; bj < 2; ++bj) { const f32x4 v0 = acc[ai][bj][m][0] * f, v1 = acc[ai][bj][m][1] * f;
                    u32x4 w; w.x = cvt_pk_bf16(v0[0], v0[1]); w.y = cvt_pk_bf16(v0[2], v0[3]); w.z = cvt_pk_bf16(v1[0], v1[1]); w.w = cvt_pk_bf16(v1[2], v1[3]);
                    *(u32x4*)(rowp + bj * HALF) = w; }
            }
        asm volatile("s_waitcnt lgkmcnt(0)" ::: "memory"); __builtin_amdgcn_s_barrier(); asm volatile("" ::: "memory");
    }
};
struct EpiSoftmax2 {
    static constexpr bool PERM = true;
    bf16_t* P; float c2; const float* part; const float* GK; const float* BK; float* stats1;
    __device__ __forceinline__ void operator()(Acc& acc, const GUnit& u, int wr, int wc, int fr, int fq, LAS unsigned char* xl, int wid, int lane) const {
        panel_stats_from_parts(part, u.x0, xl, wid * 64 + lane, u.pn == 0 ? stats1 : nullptr);
        const LAS f32x2* st = (const LAS f32x2*)xl; LAS f32x2* tab = (LAS f32x2*)(xl + 2048);
        const int b = u.pm >> 6, gcol = b * 1024 + u.x1 + wc * 32 + 8 * fq;
        f32x4 Gv[2][2], Bv[2][2];
#pragma unroll
        for (int bj = 0; bj < 2; ++bj)
#pragma unroll
            for (int n = 0; n < 2; ++n) { Gv[bj][n] = *(const f32x4*)(GK + gcol + bj * HALF + 4 * n); Bv[bj][n] = *(const f32x4*)(BK + gcol + bj * HALF + 4 * n); }
        float mloc[2][4];
#pragma unroll
        for (int ai = 0; ai < 2; ++ai)
#pragma unroll
            for (int m = 0; m < 4; ++m) { const f32x2 sr = st[ai * HALF + wr * 64 + m * 16 + fr];
                float mx = -3.0e38f;
#pragma unroll
                for (int bj = 0; bj < 2; ++bj)
#pragma unroll
                    for (int n = 0; n < 2; ++n) { const f32x4 v = (acc[ai][bj][m][n] - Gv[bj][n] * sr.x) * sr.y + Bv[bj][n]; acc[ai][bj][m][n] = v; mx = fmaxf(mx, fmaxf(fmaxf(v[0], v[1]), fmaxf(v[2], v[3]))); }
                mx = xrow_max(mx);
                float s = 0.f;
#pragma unroll
                for (int bj = 0; bj < 2; ++bj)
#pragma unroll
                    for (int n = 0; n < 2; ++n) { f32x4 v = acc[ai][bj][m][n];
#pragma unroll
                        for (int j = 0; j < 4; ++j) { v[j] = __builtin_amdgcn_exp2f((v[j] - mx) * c2); s += v[j]; }
                        acc[ai][bj][m][n] = v; }
                s = xrow_sum(s);
                mloc[ai][m] = mx;
                if (fq == 0) tab[(ai * HALF + wr * 64 + m * 16 + fr) * 4 + wc] = (f32x2){mx, s};
            }
        asm volatile("s_waitcnt lgkmcnt(0)" ::: "memory"); __builtin_amdgcn_s_barrier(); asm volatile("" ::: "memory");
        const int row0 = u.x0 + wr * 64 + fr, col0 = u.x1 + wc * 32 + 8 * fq;
#pragma unroll
        for (int ai = 0; ai < 2; ++ai)
#pragma unroll
            for (int m = 0; m < 4; ++m) {
                const int r = ai * HALF + wr * 64 + m * 16 + fr;
                const f32x2 t0 = tab[r * 4 + 0], t1 = tab[r * 4 + 1], t2 = tab[r * 4 + 2], t3 = tab[r * 4 + 3];
                const float M = fmaxf(fmaxf(t0.x, t1.x), fmaxf(t2.x, t3.x));
                const float tot = t0.y * __builtin_amdgcn_exp2f((t0.x - M) * c2) + t1.y * __builtin_amdgcn_exp2f((t1.x - M) * c2) + t2.y * __builtin_amdgcn_exp2f((t2.x - M) * c2) + t3.y * __builtin_amdgcn_exp2f((t3.x - M) * c2);
                const float f = __builtin_amdgcn_exp2f((mloc[ai][m] - M) * c2) / tot;
                bf16_t* rowp = P + (size_t)(row0 + ai * HALF + m * 16) * 1024 + col0;
#pragma unroll
                for (int bj = 0; bj < 2; ++bj) { const f32x4 v0 = acc[ai][bj][m][0] * f, v1 = acc[ai][bj][m][1] * f;
                    u32x4 w; w.x = cvt_pk_bf16(v0[0], v0[1]); w.y = cvt_pk_bf16(v0[2], v0[3]); w.z = cvt_pk_bf16(v1[0], v1[1]); w.w = cvt_pk_bf16(v1[2], v1[3]);
                    *(u32x4*)(rowp + bj * HALF) = w; }
            }
        asm volatile("s_waitcnt lgkmcnt(0)" ::: "memory"); __builtin_amdgcn_s_barrier(); asm volatile("" ::: "memory");
    }
};
struct EpiSwiGLU {
    static constexpr bool PERM = true;
    bf16_t* H; const unsigned char* ws; const LAS int* cnt;
    __device__ __forceinline__ void operator()(Acc& acc, const GUnit& u, int wr, int wc, int fr, int fq, LAS unsigned char* xl, int wid, int lane) const {
        const unsigned char* wsb = opaque_uniform(ws);
        const int* slot = (const int*)(wsb + WS_SLOT); const float* stats2 = (const float*)(wsb + WS_STATS2); const float* G13 = (const float*)(wsb + WS_G13); const float* B13 = (const float*)(wsb + WS_B13);
        LAS f32x2* tab = (LAS f32x2*)xl; LAS float* Gl = (LAS float*)(xl + 2048); LAS float* Bl = Gl + 256;
        { const int t = otid(), e = u.pm;
          if (t < 256) { const int idx = (u.x1 & 0xffff) * 256 + t; int tok = 0; if (idx < cnt[e]) tok = slot[(size_t)e * CAP + idx] >> 1; tab[t] = *(const f32x2*)(stats2 + (size_t)tok * 2); }
          else { const int cI = e * 1024 + u.pn * 256 + (t - 256); Gl[t - 256] = G13[cI]; Bl[t - 256] = B13[cI]; } }
        asm volatile("s_waitcnt vmcnt(0) lgkmcnt(0)" ::: "memory"); __builtin_amdgcn_s_barrier(); asm volatile("" ::: "memory");
        const int row0 = u.x0 * 256 + wr * 64 + fr, col0 = u.pn * 128 + wc * 32 + 8 * fq, cl = wc * 32 + 8 * fq;
#pragma unroll
        for (int ai = 0; ai < 2; ++ai)
#pragma unroll
            for (int m = 0; m < 4; ++m) { const int rl = ai * HALF + wr * 64 + m * 16 + fr; const f32x2 st = tab[rl];
                bf16_t* rowp = H + (size_t)(row0 + ai * HALF + m * 16) * 512 + col0;
                float h[8];
#pragma unroll
                for (int nn = 0; nn < 2; ++nn) { const f32x4 g0 = *(const LAS f32x4*)(Gl + cl + 4 * nn), g1 = *(const LAS f32x4*)(Gl + HALF + cl + 4 * nn), b0 = *(const LAS f32x4*)(Bl + cl + 4 * nn), b1 = *(const LAS f32x4*)(Bl + HALF + cl + 4 * nn);
                    const f32x4 a4 = (acc[ai][0][m][nn] - g0 * st.x) * st.y + b0, b4 = (acc[ai][1][m][nn] - g1 * st.x) * st.y + b1;
#pragma unroll
                    for (int jj = 0; jj < 4; ++jj) { const float a = a4[jj], b = b4[jj]; h[nn * 4 + jj] = a * b / (1.0f + __builtin_amdgcn_exp2f(-a * 1.4426950408889634f)); } }
                u32x4 w; w.x = cvt_pk_bf16(h[0], h[1]); w.y = cvt_pk_bf16(h[2], h[3]); w.z = cvt_pk_bf16(h[4], h[5]); w.w = cvt_pk_bf16(h[6], h[7]);
                *(u32x4*)rowp = w; __builtin_amdgcn_sched_barrier(0); }
        asm volatile("s_waitcnt lgkmcnt(0)" ::: "memory"); __builtin_amdgcn_s_barrier(); asm volatile("" ::: "memory");
    }
};
struct EpiScatter {
    static constexpr bool PERM = true;
    bf16_t* Y; const int* slot; const LAS int* cnt;
    __device__ __forceinline__ void operator()(Acc& acc, const GUnit& u, int wr, int wc, int fr, int fq, LAS unsigned char*, int, int) const {
        const int e = u.pm, j = u.x1 & 0xffff, n = cnt[e];
        const int col0 = u.pn * 256 + wc * 32 + 8 * fq;
#pragma unroll
        for (int ai = 0; ai < 2; ++ai)
#pragma unroll
            for (int m = 0; m < 4; ++m) { const int idx = j * 256 + ai * HALF + wr * 64 + m * 16 + fr;
                if (idx < n) { const int dest = slot[(size_t)e * CAP + idx]; bf16_t* rowp = Y + (size_t)dest * 2048 + col0;
#pragma unroll
                    for (int bj = 0; bj < 2; ++bj) { const f32x4 v0 = acc[ai][bj][m][0], v1 = acc[ai][bj][m][1];
                        u32x4 w; w.x = cvt_pk_bf16(v0[0], v0[1]); w.y = cvt_pk_bf16(v0[2], v0[3]); w.z = cvt_pk_bf16(v1[0], v1[1]); w.w = cvt_pk_bf16(v1[2], v1[3]);
                        *(u32x4*)(rowp + bj * HALF) = w; } } }
    }
};
}

__device__ __forceinline__ void ph_ln0(const Params& p, LAS unsigned char* lds) {
    const int tid = otid(), wid = __builtin_amdgcn_readfirstlane(tid >> 6), lane = tid & 63, m16 = lane & 15, q4 = lane >> 4;
    LAS unsigned char* xb = lds;
    LAS float* red = (LAS float*)(lds + 131072);
    LAS f32x4* pacc = (LAS f32x4*)(lds + 131072 + 1024);
    LAS float* csum = (LAS float*)(lds + 131072 + 1024 + 8192);
    bf16x8 Whi[8], Wlo[8];
    {
        float ps0 = 0.f, pb0 = 0.f;
#pragma unroll
        for (int s = 0; s < 8; ++s) { const int k0 = 256 * wid + 32 * s + 8 * q4; float w[8];
#pragma unroll
            for (int j = 0; j < 8; ++j) { const float wr = p.w_in[(size_t)(k0 + j) * NIN + NPROJ + m16]; w[j] = wr * p.ln0_g[k0 + j]; pb0 += wr * p.ln0_b[k0 + j]; ps0 += w[j]; }
            u32x4 hi, lo; hi.x = cvt_pk_bf16(w[0], w[1]); hi.y = cvt_pk_bf16(w[2], w[3]); hi.z = cvt_pk_bf16(w[4], w[5]); hi.w = cvt_pk_bf16(w[6], w[7]);
            lo.x = cvt_pk_bf16(w[0] - bflo(hi.x), w[1] - bfhi(hi.x)); lo.y = cvt_pk_bf16(w[2] - bflo(hi.y), w[3] - bfhi(hi.y));
            lo.z = cvt_pk_bf16(w[4] - bflo(hi.z), w[5] - bfhi(hi.z)); lo.w = cvt_pk_bf16(w[6] - bflo(hi.w), w[7] - bfhi(hi.w));
            Whi[s] = __builtin_bit_cast(bf16x8, hi); Wlo[s] = __builtin_bit_cast(bf16x8, lo); }
        const float a = xrow_sum(ps0), b = xrow_sum(pb0);
        if (lane < 16) { csum[wid * 32 + lane] = a; csum[wid * 32 + 16 + lane] = b; }
        __syncthreads();
        if (tid < 32) { float t = 0.f;
#pragma unroll
            for (int w8 = 0; w8 < 8; ++w8) t += csum[w8 * 32 + tid];
            csum[256 + tid] = t; }
        __syncthreads();
    }
    bf16_t* h0b = (bf16_t*)(p.ws + WS_REGA); float* ab = (float*)(p.ws + WS_AB);
#define LN_DMA(rb) do { _Pragma("unroll") for (int _i = 0; _i < 16; ++_i) { const int _seg = wid * 16 + _i, _r = _seg >> 3, _sg = _seg & 7; \
        __builtin_amdgcn_global_load_lds((const unsigned*)(p.x + (size_t)((rb) + _r) * DM + (_sg * 64 + (lane ^ _r)) * 4), (LAS unsigned*)(xb + _seg * 1024), 16, 0, 0); } } while (0)
    for (int blk = blockIdx.x; blk < T_TOK / 128; blk += gridDim.x) {
        const int rowbase = blk * 128;
        LN_DMA(rowbase);
        for (int bt = 0; bt < 8; ++bt) { const int rb = rowbase + bt * 16;
            asm volatile("s_waitcnt vmcnt(0)" ::: "memory"); __builtin_amdgcn_s_barrier(); asm volatile("" ::: "memory");
            f32x4 xv[8][2];
#pragma unroll
            for (int s = 0; s < 8; ++s)
#pragma unroll
                for (int h = 0; h < 2; ++h) xv[s][h] = *(const LAS f32x4*)(xb + m16 * 8192 + (((64 * wid + 8 * s + 2 * q4 + h) ^ m16) << 4));
            asm volatile("s_waitcnt lgkmcnt(0)" ::: "memory"); __builtin_amdgcn_s_barrier(); asm volatile("" ::: "memory");
            if (bt + 1 < 8) LN_DMA(rb + 16);
            float ps = 0.f, pq = 0.f;
#pragma unroll
            for (int s = 0; s < 8; ++s)
#pragma unroll
                for (int h = 0; h < 2; ++h) { const f32x4 v = xv[s][h]; ps += (v[0] + v[1]) + (v[2] + v[3]); pq += (v[0] * v[0] + v[1] * v[1]) + (v[2] * v[2] + v[3] * v[3]); }
            ps = xrow_sum(ps); pq = xrow_sum(pq);
            if (lane < 16) *(LAS f32x2*)(red + (wid * 16 + lane) * 2) = (f32x2){ps, pq};
            f32x4 acc = (f32x4){0.f, 0.f, 0.f, 0.f};
#pragma unroll
            for (int s = 0; s < 8; ++s) { const f32x4 a0 = xv[s][0], a1 = xv[s][1];
                u32x4 hw, lw;
                hw.x = cvt_pk_bf16(a0[0], a0[1]); hw.y = cvt_pk_bf16(a0[2], a0[3]); hw.z = cvt_pk_bf16(a1[0], a1[1]); hw.w = cvt_pk_bf16(a1[2], a1[3]);
                lw.x = cvt_pk_bf16(a0[0] - bflo(hw.x), a0[1] - bfhi(hw.x)); lw.y = cvt_pk_bf16(a0[2] - bflo(hw.y), a0[3] - bfhi(hw.y));
                lw.z = cvt_pk_bf16(a1[0] - bflo(hw.z), a1[1] - bfhi(hw.z)); lw.w = cvt_pk_bf16(a1[2] - bflo(hw.w), a1[3] - bfhi(hw.w));
                const bf16x8 Ahi = __builtin_bit_cast(bf16x8, hw), Alo = __builtin_bit_cast(bf16x8, lw);
                acc = __builtin_amdgcn_mfma_f32_16x16x32_bf16(Whi[s], Ahi, acc, 0, 0, 0);
                acc = __builtin_amdgcn_mfma_f32_16x16x32_bf16(Wlo[s], Ahi, acc, 0, 0, 0);
                acc = __builtin_amdgcn_mfma_f32_16x16x32_bf16(Whi[s], Alo, acc, 0, 0, 0); }
            pacc[wid * 64 + lane] = acc;
            asm volatile("s_waitcnt lgkmcnt(0)" ::: "memory"); __builtin_amdgcn_s_barrier(); asm volatile("" ::: "memory");
            float S = 0.f, Q = 0.f;
#pragma unroll
            for (int w8 = 0; w8 < 8; ++w8) { const f32x2 t = *(const LAS f32x2*)(red + (w8 * 16 + m16) * 2); S += t.x; Q += t.y; }
            const float mean = S * (1.0f / DM), rstd = rsqrtf(fmaxf(Q * (1.0f / DM) - mean * mean, 0.f) + 1e-5f);
            bf16_t* orow = h0b + (size_t)(rb + m16) * DM + 256 * wid + 8 * q4;
#pragma unroll
            for (int s = 0; s < 8; ++s) { const int k = 256 * wid + 32 * s + 8 * q4;
                const f32x4 g0 = *(const f32x4*)(p.ln0_g + k), g1 = *(const f32x4*)(p.ln0_g + k + 4), b0 = *(const f32x4*)(p.ln0_b + k), b1 = *(const f32x4*)(p.ln0_b + k + 4);
                const f32x4 h0 = (xv[s][0] - mean) * rstd * g0 + b0, h1 = (xv[s][1] - mean) * rstd * g1 + b1;
                u32x4 w; w.x = cvt_pk_bf16(h0[0], h0[1]); w.y = cvt_pk_bf16(h0[2], h0[3]); w.z = cvt_pk_bf16(h1[0], h1[1]); w.w = cvt_pk_bf16(h1[2], h1[3]);
                *(u32x4*)(orow + 32 * s) = w; }
            if (wid == (bt & 7)) {
                f32x4 t = (f32x4){0.f, 0.f, 0.f, 0.f};
#pragma unroll
                for (int w8 = 0; w8 < 8; ++w8) t += pacc[w8 * 64 + lane];
                f32x4 o;
#pragma unroll
                for (int r = 0; r < 4; ++r) o[r] = rstd * (t[r] - mean * csum[256 + 4 * q4 + r]) + csum[256 + 16 + 4 * q4 + r];
                *(f32x4*)(ab + (size_t)(rb + m16) * 16 + 4 * q4) = o; }
        }
        __syncthreads();
    }
#undef LN_DMA
    bf16_t* memb = (bf16_t*)(p.ws + WS_MEMB);
    for (int i = blockIdx.x * NTHR + tid; i < 512 * 2048 / 4; i += gridDim.x * NTHR) { const f32x4 m = *(const f32x4*)(p.mem + (size_t)i * 4);
        u32x2 w; w.x = cvt_pk_bf16(m[0], m[1]); w.y = cvt_pk_bf16(m[2], m[3]); *(u32x2*)(memb + (size_t)i * 4) = w; }
}

struct TrJob { const float* src; int lds_, col0, k0; bf16_t* dst; int ldd; const float* gk; const float* bk; float* Gn; float* Bn; };
template <bool FOLD>
__device__ __forceinline__ void transpose_batch(const TrJob (&J)[4], int nj, LAS float* tiles, f32x4& ag, f32x4& ab) {
    const int tid = otid(); const int kr = tid >> 4, c4 = tid & 15;
    f32x4 v[4][2]; float gs[4][2], bs[4][2];
#pragma unroll
    for (int t = 0; t < 4; ++t) if (t < nj) {
#pragma unroll
        for (int pss = 0; pss < 2; ++pss) { v[t][pss] = *(const f32x4*)(J[t].src + (size_t)(J[t].k0 + kr + pss * 32) * J[t].lds_ + J[t].col0 + c4 * 4);
            if constexpr (FOLD) { gs[t][pss] = J[t].gk[J[t].k0 + kr + pss * 32]; bs[t][pss] = J[t].bk[J[t].k0 + kr + pss * 32]; } } }
#pragma unroll
    for (int t = 0; t < 4; ++t) if (t < nj) { LAS float* tile = tiles + t * 4160;
#pragma unroll
        for (int pss = 0; pss < 2; ++pss) { const int k = kr + pss * 32;
            if constexpr (FOLD) { ab += v[t][pss] * bs[t][pss]; v[t][pss] *= gs[t][pss]; ag += v[t][pss]; }
            tile[k * 65 + c4 * 4 + 0] = v[t][pss][0]; tile[k * 65 + c4 * 4 + 1] = v[t][pss][1]; tile[k * 65 + c4 * 4 + 2] = v[t][pss][2]; tile[k * 65 + c4 * 4 + 3] = v[t][pss][3]; } }
    __syncthreads();
    { const int n = tid >> 3, kc = tid & 7;
#pragma unroll
        for (int t = 0; t < 4; ++t) if (t < nj) { const LAS float* tile = tiles + t * 4160; float f[8];
#pragma unroll
            for (int j = 0; j < 8; ++j) f[j] = tile[(kc * 8 + j) * 65 + n];
            u32x4 w; w.x = cvt_pk_bf16(f[0], f[1]); w.y = cvt_pk_bf16(f[2], f[3]); w.z = cvt_pk_bf16(f[4], f[5]); w.w = cvt_pk_bf16(f[6], f[7]);
            *(u32x4*)(J[t].dst + (size_t)n * J[t].ldd + J[t].k0 + kc * 8) = w; } }
    __syncthreads();
}
constexpr int TR_WIN = 96 * 32, TR_SQ = 32 * 32, TR_W13 = NEXP * 16 * 32, TR_W2 = NEXP * 32 * 8;
constexpr int TR_SMALL = TR_WIN + 4 * TR_SQ, TR_ALL = TR_SMALL + TR_W13 + TR_W2;
__device__ __forceinline__ TrJob tr_job(const Params& p, int id) {
    if (id < TR_WIN) { const int nt = id / 32, kt = id % 32; return TrJob{p.w_in, NIN, nt * 64, kt * 64, (bf16_t*)(p.ws + WS_WINT) + (size_t)nt * 64 * DM, DM, nullptr, nullptr, nullptr, nullptr}; }
    id -= TR_WIN;
    if (id < 4 * TR_SQ) { const int w4 = id / TR_SQ, w = w4 == 0 ? 0 : w4 + 1, r = id % TR_SQ, nt = r / 32, kt = r % 32;
        const float* src = w == 0 ? p.w_out : w == 2 ? p.wk : w == 3 ? p.wv : p.wo;
        TrJob j{src, DM, nt * 64, kt * 64, (bf16_t*)(p.ws + WS_WOUTT + (size_t)w * 8 * MiB) + (size_t)nt * 64 * DM, DM, nullptr, nullptr, nullptr, nullptr};
        return j; }
    id -= 4 * TR_SQ;
    if (id < TR_W13) { const int e = id / 512, r = id % 512, ntile = r / 32, kt = r % 32, n0 = ntile * 64, pn = n0 / 256, rr = n0 % 256;
        const float* src = (rr < 128 ? p.w1 : p.w3) + (size_t)e * DM * 512;
        return TrJob{src, 512, pn * 128 + (rr & 127), kt * 64, (bf16_t*)(p.ws + WS_W13T) + ((size_t)e * 1024 + n0) * DM, DM, p.ln2_g, p.ln2_b, (float*)(p.ws + WS_G13) + (size_t)e * 1024 + n0, (float*)(p.ws + WS_B13) + (size_t)e * 1024 + n0}; }
    id -= TR_W13;
    { const int e = id / 256, r = id % 256, ntile = r / 8, kt = r % 8;
        return TrJob{p.w2 + (size_t)e * 512 * DM, DM, ntile * 64, kt * 64, (bf16_t*)(p.ws + WS_W2T) + ((size_t)e * 2048 + ntile * 64) * 512, 512, nullptr, nullptr, nullptr, nullptr}; }
}
__device__ __forceinline__ void ph_transpose(const Params& p, LAS unsigned char* lds, int lo, int hi, int rank, int nwg) {
    for (int id = lo + rank * 4; id < hi; id += nwg * 4) { TrJob J[4]; const int nj = (hi - id) < 4 ? (hi - id) : 4;
#pragma unroll
        for (int t = 0; t < 4; ++t) J[t] = tr_job(p, id + (t < nj ? t : 0));
        f32x4 ag, ab; transpose_batch<false>(J, nj, (LAS float*)lds, ag, ab); }
}
__device__ __forceinline__ void ph_transpose_experts(const Params& p, LAS unsigned char* lds, LAS unsigned char* xl) {
    unsigned* ctr = (unsigned*)(p.ws + WS_CTL + CTL_TRQ); LAS int* sh = (LAS int*)xl;
    __syncthreads();
    if (otid() == 0) sh[0] = (int)atomicAdd(ctr, 1u);
    __syncthreads();
    int s = __builtin_amdgcn_readfirstlane(sh[0]);
    while (s < 1024 + 2048) {
        int nxt = 0; if (otid() == 0) nxt = (int)atomicAdd(ctr, 1u);
        const int lo = s < 1024 ? TR_SMALL + s * 32 : TR_SMALL + TR_W13 + (s - 1024) * 8, n = s < 1024 ? 32 : 8;
        if (s < 1024) { f32x4 ag = (f32x4){0.f, 0.f, 0.f, 0.f}, ab = ag;
            for (int id = lo; id < lo + n; id += 4) { TrJob J[4];
#pragma unroll
                for (int t = 0; t < 4; ++t) J[t] = tr_job(p, id + t);
                transpose_batch<true>(J, 4, (LAS float*)lds, ag, ab); }
            LAS float* red = (LAS float*)lds; const int tid = otid(), kr = tid >> 4, c4 = tid & 15;
            *(LAS f32x4*)(red + kr * 128 + c4 * 4) = ag; *(LAS f32x4*)(red + kr * 128 + 64 + c4 * 4) = ab;
            __syncthreads();
            if (tid < 128) { float sum = 0.f;
#pragma unroll
                for (int i = 0; i < 32; ++i) sum += red[i * 128 + tid];
                ((float*)(p.ws + (tid < 64 ? WS_G13 : WS_B13)))[s * 64 + (tid & 63)] = sum; } }
        else { f32x4 ag, ab;
            for (int id = lo; id < lo + n; id += 4) { TrJob J[4];
#pragma unroll
                for (int t = 0; t < 4; ++t) J[t] = tr_job(p, id + t);
                transpose_batch<false>(J, 4, (LAS float*)lds, ag, ab); } }
        if (otid() == 0) sh[0] = nxt;
        __syncthreads();
        s = __builtin_amdgcn_readfirstlane(sh[0]);
        __syncthreads();
    }
}

__device__ __forceinline__ void ln_row(f32x4 (&v)[8], const float* g, const float* b, int lane) {
    float s = 0.f;
#pragma unroll
    for (int j = 0; j < 8; ++j) s += (v[j][0] + v[j][1]) + (v[j][2] + v[j][3]);
    const float mean = wave_sum(s) * (1.0f / DM); float q = 0.f;
#pragma unroll
    for (int j = 0; j < 8; ++j) { const f32x4 d = v[j] - mean; q += (d[0] * d[0] + d[1] * d[1]) + (d[2] * d[2] + d[3] * d[3]); }
    const float rstd = rsqrtf(wave_sum(q) * (1.0f / DM) + 1e-5f);
#pragma unroll
    for (int j = 0; j < 8; ++j) { const f32x4 gg = *(const f32x4*)(g + j * 256 + lane * 4), bb = *(const f32x4*)(b + j * 256 + lane * 4); v[j] = (v[j] - mean) * rstd * gg + bb; }
}
__device__ __forceinline__ void ph_ln1(const Params& p) {
    const int tid = otid(), wid = tid >> 6, lane = tid & 63;
    const float* stats = (const float*)(p.ws + WS_STATS0); const bf16_t* mix = (const bf16_t*)p.out;
    bf16_t* h1b = (bf16_t*)(p.ws + WS_REGB);
    const int rstep = gridDim.x * 8; int row = blockIdx.x * 8 + wid;
    f32x4 nx[8]; u32x2 nm[8];
    if (row < T_TOK) {
#pragma unroll
        for (int j = 0; j < 8; ++j) { const size_t o = (size_t)row * DM + j * 256 + lane * 4; nx[j] = *(const f32x4*)(p.x + o); nm[j] = *(const u32x2*)(mix + o); } }
    for (; row < T_TOK; row += rstep) {
        const float mean = stats[row * 2], rstd = stats[row * 2 + 1]; f32x4 v[8]; u32x2 mw[8];
#pragma unroll
        for (int j = 0; j < 8; ++j) { v[j] = nx[j]; mw[j] = nm[j]; }
        if (row + rstep < T_TOK) {
#pragma unroll
            for (int j = 0; j < 8; ++j) { const size_t o = (size_t)(row + rstep) * DM + j * 256 + lane * 4; nx[j] = *(const f32x4*)(p.x + o); nm[j] = *(const u32x2*)(mix + o); } }
#pragma unroll
        for (int j = 0; j < 8; ++j) { const f32x4 mv = (f32x4){bflo(mw[j].x), bfhi(mw[j].x), bflo(mw[j].y), bfhi(mw[j].y)};
            const f32x4 g = *(const f32x4*)(p.ln0_g + j * 256 + lane * 4), b = *(const f32x4*)(p.ln0_b + j * 256 + lane * 4);
            v[j] = ((v[j] - mean) * rstd * g + b) * ALPHA + mv; }
        ln_row(v, p.ln1_g, p.ln1_b, lane);
#pragma unroll
        for (int j = 0; j < 8; ++j) { const size_t o = (size_t)row * DM + j * 256 + lane * 4;
            u32x2 w; w.x = cvt_pk_bf16(v[j][0], v[j][1]); w.y = cvt_pk_bf16(v[j][2], v[j][3]); *(u32x2*)(h1b + o) = w; }
    }
}
__device__ __forceinline__ void ph_ln2(const Params& p) {
    const int tid = otid(), wid = tid >> 6, lane = tid & 63;
    float* h = (float*)(p.ws + WS_REGB); bf16_t* h2b = (bf16_t*)(p.ws + WS_REGC); const float* xat = p.out;
    for (int row = blockIdx.x * 8 + wid; row < T_TOK; row += gridDim.x * 8) {
        f32x4 v[8];
#pragma unroll
        for (int j = 0; j < 8; ++j) { const size_t o = (size_t)row * DM + j * 256 + lane * 4; v[j] = *(const f32x4*)(h + o) * ALPHA + *(const f32x4*)(xat + o); }
        ln_row(v, p.ln2_g, p.ln2_b, lane);
#pragma unroll
        for (int j = 0; j < 8; ++j) { const size_t o = (size_t)row * DM + j * 256 + lane * 4; *(f32x4*)(h + o) = v[j];
            u32x2 w; w.x = cvt_pk_bf16(v[j][0], v[j][1]); w.y = cvt_pk_bf16(v[j][2], v[j][3]); *(u32x2*)(h2b + o) = w; }
    }
}
__device__ __forceinline__ void ph_ln3(const Params& p) {
    const int tid = otid(), wid = tid >> 6, lane = tid & 63;
    const bf16_t* h = (const bf16_t*)(p.ws + WS_S2); const float* gates = (const float*)(p.ws + WS_GATES); const bf16_t* y2 = (const bf16_t*)p.out; const float* stats2 = (const float*)(p.ws + WS_STATS2);
    const int rstep = gridDim.x * 8; int row = blockIdx.x * 8 + wid;
    u32x2 nh[8]; u32x2 na[8], nb[8];
    if (row < T_TOK) {
#pragma unroll
        for (int j = 0; j < 8; ++j) { nh[j] = *(const u32x2*)(h + (size_t)row * DM + j * 256 + lane * 4); na[j] = *(const u32x2*)(y2 + (size_t)(2 * row) * DM + j * 256 + lane * 4); nb[j] = *(const u32x2*)(y2 + (size_t)(2 * row + 1) * DM + j * 256 + lane * 4); } }
    for (; row < T_TOK; row += rstep) {
        const float g0 = gates[row * 2], g1 = gates[row * 2 + 1], m2 = stats2[row * 2], r2 = stats2[row * 2 + 1] * ALPHA; f32x4 v[8];
#pragma unroll
        for (int j = 0; j < 8; ++j) { const f32x4 a = (f32x4){bflo(na[j].x), bfhi(na[j].x), bflo(na[j].y), bfhi(na[j].y)}, b = (f32x4){bflo(nb[j].x), bfhi(nb[j].x), bflo(nb[j].y), bfhi(nb[j].y)};
            const f32x4 gg = *(const f32x4*)(p.ln2_g + j * 256 + lane * 4), bb = *(const f32x4*)(p.ln2_b + j * 256 + lane * 4);
            v[j] = (((f32x4){bflo(nh[j].x), bfhi(nh[j].x), bflo(nh[j].y), bfhi(nh[j].y)} - m2) * r2) * gg + bb * ALPHA + (a * g0 + b * g1); }
        if (row + rstep < T_TOK) { const int rn = row + rstep;
#pragma unroll
            for (int j = 0; j < 8; ++j) { nh[j] = *(const u32x2*)(h + (size_t)rn * DM + j * 256 + lane * 4); na[j] = *(const u32x2*)(y2 + (size_t)(2 * rn) * DM + j * 256 + lane * 4); nb[j] = *(const u32x2*)(y2 + (size_t)(2 * rn + 1) * DM + j * 256 + lane * 4); } }
        ln_row(v, p.ln3_g, p.ln3_b, lane);
#pragma unroll
        for (int j = 0; j < 8; ++j) *(f32x4*)(p.out + (size_t)row * DM + j * 256 + lane * 4) = v[j];
    }
}


__device__ __forceinline__ int kperm(int k) { return (k & ~31) | (((k >> 2) & 3) << 3) | (((k >> 4) & 1) << 2) | (k & 3); }
__device__ __forceinline__ int img256(int row, int kp) { return row * 256 + ((((kp >> 3) ^ (row & 15))) << 4) + (kp & 7) * 2; }
__device__ __forceinline__ int img128(int row, int kp) { return row * 128 + ((((kp >> 3) ^ ((row >> 1) & 7))) << 4) + (kp & 7) * 2; }
__device__ __forceinline__ bf16x8 frag256(const LAS unsigned char* base, int R, int ch) { return *(const LAS bf16x8*)(base + R * 256 + ((ch ^ (R & 15)) << 4)); }
__device__ __forceinline__ bf16x8 frag128(const LAS unsigned char* base, int R, int ch) { return *(const LAS bf16x8*)(base + R * 128 + ((ch ^ ((R >> 1) & 7)) << 4)); }
__device__ __forceinline__ int img128x(int row, int kp) { return row * 128 + ((((kp >> 3) ^ ((row >> 1) & 7) ^ ((row >> 4) & 7))) << 4) + (kp & 7) * 2; }
__device__ __forceinline__ bf16x8 frag128x(const LAS unsigned char* base, int R, int ch) { return *(const LAS bf16x8*)(base + R * 128 + ((ch ^ ((R >> 1) & 7) ^ ((R >> 4) & 7)) << 4)); }
__device__ __forceinline__ bf16x8 pack8(const f32x4 x, const f32x4 y) { u32x4 w; w.x = cvt_pk_bf16(x[0], x[1]); w.y = cvt_pk_bf16(x[2], x[3]); w.z = cvt_pk_bf16(y[0], y[1]); w.w = cvt_pk_bf16(y[2], y[3]); return __builtin_bit_cast(bf16x8, w); }
constexpr size_t GD_HREC = 40960, GD_KREC = 32768, GD_KOFF = 160 * MiB, GD_GOFF = 224 * MiB;

__device__ __forceinline__ void unpack8(const u32x4 w, float (&x)[8]) { x[0] = bflo(w.x); x[1] = bfhi(w.x); x[2] = bflo(w.y); x[3] = bfhi(w.y); x[4] = bflo(w.z); x[5] = bfhi(w.z); x[6] = bflo(w.w); x[7] = bfhi(w.w); }
__device__ __forceinline__ void conv_unit(const Params& p, const int unit, const int slot) {
    const bf16_t* proj = (const bf16_t*)(p.ws + WS_REGB); bf16_t* qkvc = (bf16_t*)(p.ws + WS_W13T) + (size_t)(blockIdx.x * 2 + slot) * 64 * DM - (size_t)unit * 64 * DM; bf16_t* mixcat = (bf16_t*)(p.ws + WS_REGC);
    const float* ab = (const float*)(p.ws + WS_AB); float* gg = (float*)(p.ws + WS_GG); float* gb = (float*)(p.ws + WS_GB);
    {
        const int t0 = unit * 64, s0 = t0 % SEQ;
        {
            const int tid = otid(), oct = tid & 255, half = tid >> 8, c0 = oct * 8, tb = t0 + half * 32, sb = s0 + half * 32;
            float w[4][8];
#pragma unroll
            for (int j = 0; j < 4; ++j) { const f32x4 w0 = *(const f32x4*)(p.gdn_conv_w + j * 2048 + c0), w1 = *(const f32x4*)(p.gdn_conv_w + j * 2048 + c0 + 4);
#pragma unroll
                for (int i = 0; i < 4; ++i) { w[j][i] = w0[i]; w[j][4 + i] = w1[i]; } }
            const bf16_t* src = proj + (size_t)tb * NPROJ + 3072 + c0;
            u32x4 win[3];
#pragma unroll
            for (int j = 0; j < 3; ++j) { win[j] = (u32x4){0u, 0u, 0u, 0u}; if (sb - 3 + j >= 0) win[j] = *(const u32x4*)(src + (ptrdiff_t)(j - 3) * NPROJ); }
            const bool isqk = oct < 128; const float nscale = oct < 64 ? 0.08838834764831845f : 1.0f;
            for (int g8 = 0; g8 < 4; ++g8) {
                u32x4 row[8];
#pragma unroll
                for (int i = 0; i < 8; ++i) row[i] = *(const u32x4*)(src + (size_t)(g8 * 8 + i) * NPROJ);
#pragma unroll
                for (int i = 0; i < 8; ++i) {
                    float x0[8], x1[8], x2[8], x3[8];
                    unpack8(i >= 3 ? row[i - 3] : win[i], x0); unpack8(i >= 2 ? row[i - 2] : win[i + 1 > 2 ? 2 : i + 1], x1); unpack8(i >= 1 ? row[i - 1] : win[2], x2); unpack8(row[i], x3);
                    float acc[8]; float ss = 0.f;
#pragma unroll
                    for (int e = 0; e < 8; ++e) { acc[e] = silu_f(w[0][e] * x0[e] + w[1][e] * x1[e] + w[2][e] * x2[e] + w[3][e] * x3[e]); ss += acc[e] * acc[e]; }
                    if (isqk) { ss = dpp_row_sum(ss); const float r = rsqrtf(ss + 1e-6f) * nscale;
#pragma unroll
                        for (int e = 0; e < 8; ++e) acc[e] *= r; }
                    u32x4 o; o.x = cvt_pk_bf16(acc[0], acc[1]); o.y = cvt_pk_bf16(acc[2], acc[3]); o.z = cvt_pk_bf16(acc[4], acc[5]); o.w = cvt_pk_bf16(acc[6], acc[7]);
                    *(u32x4*)(qkvc + (size_t)(tb + g8 * 8 + i) * DM + c0) = o;
                }
                win[0] = row[5]; win[1] = row[6]; win[2] = row[7];
            }
        }
        {
            const int tid = otid(), oct = tid & 127, qr = tid >> 7, c0 = oct * 8, tb = t0 + qr * 16, sb = s0 + qr * 16;
            float w[3][8];
#pragma unroll
            for (int j = 0; j < 3; ++j) { const f32x4 w0 = *(const f32x4*)(p.sconv_w + j * 1024 + c0), w1 = *(const f32x4*)(p.sconv_w + j * 1024 + c0 + 4);
#pragma unroll
                for (int i = 0; i < 4; ++i) { w[j][i] = w0[i]; w[j][4 + i] = w1[i]; } }
            const bf16_t* src = proj + (size_t)tb * NPROJ + c0;
            float pm2[8], pm1[8];
            { float cv[8], xv[8];
#pragma unroll
                for (int e = 0; e < 8; ++e) { pm2[e] = 0.f; pm1[e] = 0.f; }
                if (sb - 2 >= 0) { unpack8(*(const u32x4*)(src - (ptrdiff_t)2 * NPROJ + 1024), cv); unpack8(*(const u32x4*)(src - (ptrdiff_t)2 * NPROJ + 2048), xv);
#pragma unroll
                    for (int e = 0; e < 8; ++e) pm2[e] = cv[e] * xv[e]; }
                if (sb - 1 >= 0) { unpack8(*(const u32x4*)(src - (ptrdiff_t)1 * NPROJ + 1024), cv); unpack8(*(const u32x4*)(src - (ptrdiff_t)1 * NPROJ + 2048), xv);
#pragma unroll
                    for (int e = 0; e < 8; ++e) pm1[e] = cv[e] * xv[e]; } }
            for (int g4 = 0; g4 < 4; ++g4) {
                u32x4 rb[4], rc[4], rx[4];
#pragma unroll
                for (int i = 0; i < 4; ++i) { const bf16_t* r = src + (size_t)(g4 * 4 + i) * NPROJ; rb[i] = *(const u32x4*)r; rc[i] = *(const u32x4*)(r + 1024); rx[i] = *(const u32x4*)(r + 2048); }
#pragma unroll
                for (int i = 0; i < 4; ++i) { float bv[8], cv[8], xv[8], pr[8], y[8]; unpack8(rb[i], bv); unpack8(rc[i], cv); unpack8(rx[i], xv);
#pragma unroll
                    for (int e = 0; e < 8; ++e) { pr[e] = cv[e] * xv[e]; y[e] = bv[e] * (w[0][e] * pm2[e] + w[1][e] * pm1[e] + w[2][e] * pr[e]); pm2[e] = pm1[e]; pm1[e] = pr[e]; }
                    u32x4 o; o.x = cvt_pk_bf16(y[0], y[1]); o.y = cvt_pk_bf16(y[2], y[3]); o.z = cvt_pk_bf16(y[4], y[5]); o.w = cvt_pk_bf16(y[6], y[7]);
                    *(u32x4*)(mixcat + (size_t)(tb + g4 * 4 + i) * DM + c0) = o; }
            }
        }
        {
            const int tid = otid(), t = t0 + (tid >> 3), h = tid & 7;
            const float a = ab[(size_t)t * 16 + h] + p.dt_bias[h], b = ab[(size_t)t * 16 + 8 + h];
            const float sp = a > 20.f ? a : log1pf(__expf(a));
            gg[(size_t)t * 8 + h] = -__expf(p.a_log[h]) * sp; gb[(size_t)t * 8 + h] = 1.0f / (1.0f + __expf(-b)); }
    }
}

__device__ __forceinline__ LAS unsigned char* st_addr(LAS unsigned char* lds, int off) { return lds + (off < 4096 ? 69632 + off : 139264 - 4096 + off); }
__device__ __forceinline__ void ph_gdn_prep(const Params& p, LAS unsigned char* lds) {
    const int wid = __builtin_amdgcn_readfirstlane(otid() >> 6);
    LAS float* Gs = (LAS float*)(lds); LAS float* Bs = (LAS float*)(lds + 2048);
    LAS float* KK = (LAS float*)(lds + 4096);
    LAS unsigned char* TM = lds + 4096;
    LAS unsigned char* KS = lds + 4096 + 69632; LAS unsigned char* QS = KS + 16384; LAS unsigned char* RTV = QS + 16384; LAS unsigned char* RTK = RTV + 16384;
    const float* gg = (const float*)(p.ws + WS_GG); const float* gb = (const float*)(p.ws + WS_GB);
    unsigned char* gd = (unsigned char*)p.out;
    const int nun = (512 - (int)blockIdx.x + (int)gridDim.x - 1) / (int)gridDim.x; const bool ahead = (blockIdx.x & 1) && nun == 2;
    for (int step = 0; step < 2 * nun; ++step) {
        const bool isconv = ahead ? (step < nun) : !(step & 1); const int kk = ahead ? (isconv ? step : step - nun) : (step >> 1), slot = kk & 1;
        const int unit = blockIdx.x + kk * gridDim.x;
        const int b = unit >> 8, n = unit & 255; const size_t t0 = (size_t)b * SEQ + (size_t)n * 64;
        const bf16_t* qkvc = (const bf16_t*)(p.ws + WS_W13T) + (size_t)(blockIdx.x * 2 + slot) * 64 * DM - t0 * DM;
        if (isconv) {
            conv_unit(p, unit, slot);
            asm volatile("s_waitcnt vmcnt(0)" ::: "memory");
            __syncthreads();
            if (otid() == 0) { __builtin_amdgcn_fence(__ATOMIC_ACQUIRE, "agent"); asm volatile("s_waitcnt vmcnt(0)" ::: "memory"); }
            __syncthreads();
            continue; }
        { const int lane = otid() & 63; const int h = wid; float g = gg[(t0 + lane) * 8 + h]; const float bt = gb[(t0 + lane) * 8 + h];
            g = wave_scan(g);
            Gs[h * 64 + lane] = g; Bs[h * 64 + lane] = bt;
            ((float*)(gd + GD_GOFF))[((size_t)(b * 8 + h) * 256 + n) * 64 + lane] = g; }
        for (int kh = 0; kh < 4; ++kh) {
            const int tidA = otid(), jrow = tidA >> 3, part = tidA & 7, m16 = tidA & 15, q4 = (tidA >> 4) & 3;
            { const bf16_t* src = qkvc + (t0 + jrow) * DM + 512 + kh * 128 + part * 16;
                const u32x4 a = *(const u32x4*)src, c = *(const u32x4*)(src + 8);
                *(LAS u32x4*)(KS + img256(jrow, part * 16)) = a; *(LAS u32x4*)(KS + img256(jrow, part * 16 + 8)) = c; }
            __syncthreads();
            { const int it = wid >> 1;
#pragma unroll
                for (int jj = 0; jj < 2; ++jj) { const int jt = (wid & 1) * 2 + jj; f32x4 acc = (f32x4){0.f, 0.f, 0.f, 0.f};
#pragma unroll
                    for (int s = 0; s < 4; ++s) acc = __builtin_amdgcn_mfma_f32_16x16x32_bf16(frag256(KS, 16 * it + m16, 4 * s + q4), frag256(KS, 16 * jt + m16, 4 * s + q4), acc, 0, 0, 0);
#pragma unroll
                    for (int r = 0; r < 4; ++r) KK[kh * 64 * 68 + (16 * it + 4 * q4 + r) * 68 + 16 * jt + m16] = acc[r]; } }
            __syncthreads();
        }
        float mcol[64];
        { const int h = wid, kh = h >> 1, c = otid() & 63; const float Gc_ = Gs[h * 64 + c];
#pragma unroll
            for (int j = 0; j < 64; ++j) { const float kkv = KK[kh * 64 * 68 + j * 68 + c]; const float v = -Bs[h * 64 + j] * kkv * __expf(Gs[h * 64 + j] - Gc_); mcol[j] = (j > c) ? v : 0.f; } }
        __syncthreads();
        {
#pragma unroll
            for (int i = 1; i < 64; ++i) { const int mi = __float_as_int(mcol[i]); float a0 = mcol[i], a1 = 0.f;
#pragma unroll
                for (int j = 0; j < i; ++j) { const float s = __int_as_float(__builtin_amdgcn_readlane(mi, j)); if (j & 1) a1 += s * mcol[j]; else a0 += s * mcol[j]; }
                mcol[i] = a0 + a1; }
            LAS unsigned char* TMh = TM + wid * 8192; const int lane = otid() & 63;
#pragma unroll
            for (int i = 0; i < 64; ++i) { const float v = (i > lane) ? mcol[i] : (i == lane ? 1.0f : 0.f); *(LAS bf16_t*)(TMh + img128(i, lane)) = (bf16_t)(cvt_pk_bf16(v, 0.f) & 0xffffu); }
        }
        __syncthreads();
        u32x4 va, vb, ka, kb, qa, qb;
        { const int tidC = otid(), jrow = tidC >> 3, part = tidC & 7; const bf16_t* rowp = qkvc + (t0 + jrow) * DM;
            va = *(const u32x4*)(rowp + 1024 + part * 16); vb = *(const u32x4*)(rowp + 1024 + part * 16 + 8);
            ka = *(const u32x4*)(rowp + 512 + part * 16); kb = *(const u32x4*)(rowp + 512 + part * 16 + 8);
            qa = *(const u32x4*)(rowp + part * 16); qb = *(const u32x4*)(rowp + part * 16 + 8); }
        for (int h = 0; h < 8; ++h) {
            const int kh = h >> 1; const int tidC = otid(), jrow = tidC >> 3, part = tidC & 7, lane = tidC & 63, m16 = tidC & 15, q4 = (tidC >> 4) & 3;
            unsigned char* hrec = gd + ((size_t)(b * 8 + h) * 256 + n) * GD_HREC; unsigned char* krec = gd + GD_KOFF + ((size_t)(b * 4 + kh) * 256 + n) * GD_KREC;
            { const float bj = Bs[h * 64 + jrow], be = bj * __expf(Gs[h * 64 + jrow]);
                if ((h & 1) == 0) {
                    *(LAS u32x4*)(KS + img256(jrow, part * 16)) = ka; *(LAS u32x4*)(KS + img256(jrow, part * 16 + 8)) = kb;
                    *(LAS u32x4*)(QS + img256(jrow, part * 16)) = qa; *(LAS u32x4*)(QS + img256(jrow, part * 16 + 8)) = qb; }
                const unsigned vw[8] = {va.x, va.y, va.z, va.w, vb.x, vb.y, vb.z, vb.w}, kw[8] = {ka.x, ka.y, ka.z, ka.w, kb.x, kb.y, kb.z, kb.w}, qw[8] = {qa.x, qa.y, qa.z, qa.w, qb.x, qb.y, qb.z, qb.w};
#pragma unroll
                for (int e = 0; e < 8; ++e) { const int c = part * 16 + 2 * e;
                    const unsigned pv = cvt_pk_bf16(bflo(vw[e]) * bj, bfhi(vw[e]) * bj), pk = cvt_pk_bf16(bflo(kw[e]) * be, bfhi(kw[e]) * be);
                    *(LAS bf16_t*)(RTV + img128x(c, jrow)) = (bf16_t)(pv & 0xffffu); *(LAS bf16_t*)(RTV + img128x(c + 1, jrow)) = (bf16_t)(pv >> 16);
                    *(LAS bf16_t*)(RTK + img128x(c, jrow)) = (bf16_t)(pk & 0xffffu); *(LAS bf16_t*)(RTK + img128x(c + 1, jrow)) = (bf16_t)(pk >> 16); }
                if ((h & 1) == 0) {
                    const int jp = kperm(jrow);
#pragma unroll
                    for (int e = 0; e < 4; ++e) { const int c = part * 16 + 4 * e; u32x2 w; w.x = qw[2 * e]; w.y = qw[2 * e + 1]; *(u32x2*)(krec + img256(jrow, kperm(c))) = w; }
#pragma unroll
                    for (int e = 0; e < 8; ++e) { const int c = part * 16 + 2 * e; *(LAS bf16_t*)st_addr(lds, img128(c, jp)) = (bf16_t)(kw[e] & 0xffffu); *(LAS bf16_t*)st_addr(lds, img128(c + 1, jp)) = (bf16_t)(kw[e] >> 16); }
                } }
            __syncthreads();
            if ((h & 1) == 0) {
                const u32x4 s0 = *(const LAS u32x4*)st_addr(lds, tidC * 32), s1 = *(const LAS u32x4*)st_addr(lds, tidC * 32 + 16);
                *(u32x4*)(krec + 16384 + tidC * 32) = s0; *(u32x4*)(krec + 16384 + tidC * 32 + 16) = s1; }
            if (h + 1 < 8) { const int h1 = h + 1, kh1 = h1 >> 1; const bf16_t* rowp = qkvc + (t0 + jrow) * DM;
                va = *(const u32x4*)(rowp + 1024 + h1 * 128 + part * 16); vb = *(const u32x4*)(rowp + 1024 + h1 * 128 + part * 16 + 8);
                if ((h1 & 1) == 0) { ka = *(const u32x4*)(rowp + 512 + kh1 * 128 + part * 16); kb = *(const u32x4*)(rowp + 512 + kh1 * 128 + part * 16 + 8);
                    qa = *(const u32x4*)(rowp + kh1 * 128 + part * 16); qb = *(const u32x4*)(rowp + kh1 * 128 + part * 16 + 8); } }
            const LAS unsigned char* TMh = TM + h * 8192;
            {
#pragma unroll
                for (int it = 0; it < 4; ++it) { f32x4 acc = (f32x4){0.f, 0.f, 0.f, 0.f};
#pragma unroll
                    for (int s = 0; s < 2; ++s) acc = __builtin_amdgcn_mfma_f32_16x16x32_bf16(frag128x(RTK, 16 * wid + m16, 4 * s + q4), frag128(TMh, 16 * it + m16, 4 * s + q4), acc, 0, 0, 0);
                    const int i = 16 * it + m16, kp0 = 32 * (wid >> 1) + 8 * q4 + 4 * (wid & 1);
                    u32x2 w; w.x = cvt_pk_bf16(-acc[0], -acc[1]); w.y = cvt_pk_bf16(-acc[2], -acc[3]); *(u32x2*)(hrec + img256(i, kp0)) = w; }
                unsigned uw[8];
#pragma unroll
                for (int rt = 0; rt < 4; ++rt) { f32x4 acc = (f32x4){0.f, 0.f, 0.f, 0.f};
#pragma unroll
                    for (int s = 0; s < 2; ++s) acc = __builtin_amdgcn_mfma_f32_16x16x32_bf16(frag128(TMh, 16 * rt + m16, 4 * s + q4), frag128x(RTV, 16 * wid + m16, 4 * s + q4), acc, 0, 0, 0);
                    uw[2 * rt] = cvt_pk_bf16(acc[0], acc[1]); uw[2 * rt + 1] = cvt_pk_bf16(acc[2], acc[3]); }
                { u32x4 w0, w1; w0.x = uw[0]; w0.y = uw[1]; w0.z = uw[2]; w0.w = uw[3]; w1.x = uw[4]; w1.y = uw[5]; w1.z = uw[6]; w1.w = uw[7];
                  unsigned char* up = hrec + 24576 + (size_t)(wid * 64 + lane) * 32; *(u32x4*)up = w0; *(u32x4*)(up + 16) = w1; }
                const int it = wid >> 1, i = 16 * it + m16; const float Gi = Gs[h * 64 + i];
#pragma unroll
                for (int jj = 0; jj < 2; ++jj) { const int jt = (wid & 1) * 2 + jj; f32x4 acc = (f32x4){0.f, 0.f, 0.f, 0.f};
#pragma unroll
                    for (int s = 0; s < 4; ++s) acc = __builtin_amdgcn_mfma_f32_16x16x32_bf16(frag256(KS, 16 * jt + m16, 4 * s + q4), frag256(QS, 16 * it + m16, 4 * s + q4), acc, 0, 0, 0);
                    float v[4];
#pragma unroll
                    for (int r = 0; r < 4; ++r) { const int j = 16 * jt + 4 * q4 + r; v[r] = (j <= i) ? acc[r] * __expf(Gi - Gs[h * 64 + j]) : 0.f; }
                    const int kp0 = 32 * (jt >> 1) + 8 * q4 + 4 * (jt & 1);
                    u32x2 w; w.x = cvt_pk_bf16(v[0], v[1]); w.y = cvt_pk_bf16(v[2], v[3]); *(u32x2*)(hrec + 16384 + img128(i, kp0)) = w; }
            }
            __syncthreads();
        }
    }
}

constexpr size_t SC_PIMG = 225 * MiB, SC_QF = 233 * MiB;
#define GD_UNPACK_U(av, ua, ub) do { av[0] = (f32x4){bflo(ua.x), bfhi(ua.x), bflo(ua.y), bfhi(ua.y)}; av[1] = (f32x4){bflo(ua.z), bfhi(ua.z), bflo(ua.w), bfhi(ua.w)}; \
        av[2] = (f32x4){bflo(ub.x), bfhi(ub.x), bflo(ub.y), bfhi(ub.y)}; av[3] = (f32x4){bflo(ub.z), bfhi(ub.z), bflo(ub.w), bfhi(ub.w)}; } while (0)

__device__ __forceinline__ void ph_gdn_passA(const Params& p, LAS unsigned char* lds) {
    const int tid = otid(), wid = __builtin_amdgcn_readfirstlane(tid >> 6), lane = tid & 63, m16 = lane & 15, q4 = lane >> 4;
    const unsigned char* gd = (const unsigned char*)p.out;
    for (int id = blockIdx.x; id < 256; id += gridDim.x) {
        const int b = id >> 7, h = (id >> 4) & 7, kh = h >> 1, n0 = (id & 15) * 16;
        const unsigned char* hrec0 = gd + ((size_t)(b * 8 + h) * 256 + n0) * GD_HREC; const unsigned char* krec0 = gd + GD_KOFF + ((size_t)(b * 4 + kh) * 256 + n0) * GD_KREC;
        const float* Gc0 = (const float*)(gd + GD_GOFF) + ((size_t)(b * 8 + h) * 256 + n0) * 64;
        constexpr int BUFA = 32768;
#define GA_DMA(nn, bufi) do { const unsigned char* _hr = hrec0 + (size_t)(nn) * GD_HREC; const unsigned char* _kr = krec0 + (size_t)(nn) * GD_KREC + 16384; \
        _Pragma("unroll") for (int _k = 0; _k < 4; ++_k) { const int _pc = wid + 8 * _k; const unsigned char* _src = (_pc < 16 ? _hr + _pc * 1024 : _kr + (_pc - 16) * 1024) + lane * 16; \
            __builtin_amdgcn_global_load_lds((const unsigned*)_src, (LAS unsigned*)(lds + (bufi) * BUFA + _pc * 1024), 16, 0, 0); } } while (0)
        f32x4 Ps[8], Qs[8]; const int lz = otid() & 63, mz = lz & 15, qz = lz >> 4;
#pragma unroll
        for (int a = 0; a < 8; ++a) { Qs[a] = (f32x4){0.f, 0.f, 0.f, 0.f};
#pragma unroll
            for (int r = 0; r < 4; ++r) Ps[a][r] = (16 * a + 4 * qz + r == 16 * wid + mz) ? 1.0f : 0.f; }
        GA_DMA(0, 0);
        u32x4 ua = *(const u32x4*)(hrec0 + 24576 + (size_t)(wid * 64 + lane) * 32), ub = *(const u32x4*)(hrec0 + 24576 + (size_t)(wid * 64 + lane) * 32 + 16);
        f32x4 gv[4]; float G63 = Gc0[63];
#pragma unroll
        for (int rt = 0; rt < 4; ++rt) gv[rt] = *(const f32x4*)(Gc0 + 16 * rt + 4 * q4);
        GA_DMA(1, 1);
        for (int n = 0; n < 16; ++n) {
            const int cur = n % 3, nn = (n + 1 < 16) ? n + 1 : n;
            if (n + 1 < 16) asm volatile("s_waitcnt vmcnt(4)" ::: "memory"); else asm volatile("s_waitcnt vmcnt(0)" ::: "memory");
            __builtin_amdgcn_s_barrier();
            const unsigned char* hrn = hrec0 + (size_t)nn * GD_HREC; const float* Gn = Gc0 + (size_t)nn * 64;
            const u32x4 ua_n = *(const u32x4*)(hrn + 24576 + (size_t)(wid * 64 + lane) * 32), ub_n = *(const u32x4*)(hrn + 24576 + (size_t)(wid * 64 + lane) * 32 + 16);
            f32x4 gv_n[4]; const float G63_n = Gn[63];
#pragma unroll
            for (int rt = 0; rt < 4; ++rt) gv_n[rt] = *(const f32x4*)(Gn + 16 * rt + 4 * q4);
            asm volatile("" ::: "memory");
            if (n + 2 < 16) GA_DMA(n + 2, (n + 2) % 3);
            const LAS unsigned char* WN = lds + cur * BUFA; const LAS unsigned char* KT = WN + 16384;
            f32x4 ek[4];
#pragma unroll
            for (int rt = 0; rt < 4; ++rt) {
#pragma unroll
                for (int r = 0; r < 4; ++r) ek[rt][r] = __expf(G63 - gv[rt][r]); }
            const float gam = __expf(G63);
            bf16x8 SBp[4], SBq[4];
#pragma unroll
            for (int s = 0; s < 4; ++s) { SBp[s] = pack8(Ps[2 * s], Ps[2 * s + 1]); SBq[s] = pack8(Qs[2 * s], Qs[2 * s + 1]); }
            f32x4 vp[4], vq[4]; GD_UNPACK_U(vq, ua, ub);
#pragma unroll
            for (int rt = 0; rt < 4; ++rt) { vp[rt] = (f32x4){0.f, 0.f, 0.f, 0.f};
#pragma unroll
                for (int s = 0; s < 4; ++s) { const bf16x8 wf = frag256(WN, 16 * rt + m16, 4 * s + q4);
                    vp[rt] = __builtin_amdgcn_mfma_f32_16x16x32_bf16(wf, SBp[s], vp[rt], 0, 0, 0); vq[rt] = __builtin_amdgcn_mfma_f32_16x16x32_bf16(wf, SBq[s], vq[rt], 0, 0, 0); } }
            bf16x8 VBp[2], VBq[2];
#pragma unroll
            for (int s2 = 0; s2 < 2; ++s2) { VBp[s2] = pack8(vp[2 * s2] * ek[2 * s2], vp[2 * s2 + 1] * ek[2 * s2 + 1]); VBq[s2] = pack8(vq[2 * s2] * ek[2 * s2], vq[2 * s2 + 1] * ek[2 * s2 + 1]); }
#pragma unroll
            for (int a = 0; a < 8; ++a) { Ps[a] = Ps[a] * gam; Qs[a] = Qs[a] * gam;
#pragma unroll
                for (int s2 = 0; s2 < 2; ++s2) { const bf16x8 kf = frag128(KT, 16 * a + m16, 4 * s2 + q4);
                    Ps[a] = __builtin_amdgcn_mfma_f32_16x16x32_bf16(kf, VBp[s2], Ps[a], 0, 0, 0); Qs[a] = __builtin_amdgcn_mfma_f32_16x16x32_bf16(kf, VBq[s2], Qs[a], 0, 0, 0); } }
            ua = ua_n; ub = ub_n; G63 = G63_n;
#pragma unroll
            for (int rt = 0; rt < 4; ++rt) gv[rt] = gv_n[rt];
        }
        unsigned char* pimg = (unsigned char*)p.out + SC_PIMG + (size_t)id * 32768; f32x4* qf = (f32x4*)((unsigned char*)p.out + SC_QF + (size_t)id * 65536);
        const int le = otid() & 63, kp = kperm(16 * wid + (le & 15));
#pragma unroll
        for (int a = 0; a < 8; ++a) { qf[(wid * 8 + a) * 64 + le] = Qs[a];
#pragma unroll
            for (int r = 0; r < 4; r += 2) { const unsigned w = cvt_pk_bf16(Ps[a][r], Ps[a][r + 1]); const int kf = 16 * a + 4 * (le >> 4) + r;
                *(bf16_t*)(pimg + img256(kf, kp)) = (bf16_t)(w & 0xffffu); *(bf16_t*)(pimg + img256(kf + 1, kp)) = (bf16_t)(w >> 16); } }
        asm volatile("s_waitcnt vmcnt(0)" ::: "memory"); __syncthreads();
#undef GA_DMA
    }
}
__device__ __forceinline__ void ph_gdn_combine(const Params& p, LAS unsigned char* lds) {
    const int tid = otid(), wid = __builtin_amdgcn_readfirstlane(tid >> 6), lane = tid & 63, m16 = lane & 15, q4 = lane >> 4;
    const int bh = blockIdx.x;
    const unsigned char* pimg0 = (const unsigned char*)p.out + SC_PIMG + (size_t)bh * 16 * 32768; const f32x4* qf0 = (const f32x4*)((const unsigned char*)p.out + SC_QF + (size_t)bh * 16 * 65536);
    f32x4* sin0 = (f32x4*)(p.ws + WS_SIN + (size_t)bh * 16 * 65536);
#define GC_DMA(sg, bufi) do { _Pragma("unroll") for (int _k = 0; _k < 4; ++_k) { const int _pc = wid + 8 * _k; \
        __builtin_amdgcn_global_load_lds((const unsigned*)(pimg0 + (size_t)(sg) * 32768 + _pc * 1024 + lane * 16), (LAS unsigned*)(lds + (bufi) * 32768 + _pc * 1024), 16, 0, 0); } } while (0)
    f32x4 S[8];
#pragma unroll
    for (int a = 0; a < 8; ++a) S[a] = (f32x4){0.f, 0.f, 0.f, 0.f};
    GC_DMA(0, 0);
    for (int sg = 0; sg < 16; ++sg) {
        const int cur = sg & 1;
        f32x4 qv[8];
#pragma unroll
        for (int a = 0; a < 8; ++a) { sin0[((size_t)sg * 64 + wid * 8 + a) * 64 + lane] = S[a]; qv[a] = qf0[((size_t)sg * 64 + wid * 8 + a) * 64 + lane]; }
        asm volatile("s_waitcnt vmcnt(0)" ::: "memory"); __builtin_amdgcn_s_barrier();
        if (sg + 1 < 16) GC_DMA(sg + 1, cur ^ 1);
        const LAS unsigned char* PI = lds + cur * 32768;
        bf16x8 SB[4];
#pragma unroll
        for (int s = 0; s < 4; ++s) SB[s] = pack8(S[2 * s], S[2 * s + 1]);
#pragma unroll
        for (int a = 0; a < 8; ++a) { f32x4 acc = qv[a];
#pragma unroll
            for (int s = 0; s < 4; ++s) acc = __builtin_amdgcn_mfma_f32_16x16x32_bf16(frag256(PI, 16 * a + m16, 4 * s + q4), SB[s], acc, 0, 0, 0);
            S[a] = acc; }
    }
    asm volatile("s_waitcnt vmcnt(0)" ::: "memory"); __syncthreads();
#undef GC_DMA
}
__device__ __forceinline__ void ph_gdn_passB(const Params& p, LAS unsigned char* lds) {
    const int tid = otid(), wid = __builtin_amdgcn_readfirstlane(tid >> 6), lane = tid & 63, m16 = lane & 15, q4 = lane >> 4;
    const unsigned char* gd = (const unsigned char*)p.out;
    const bf16_t* proj = (const bf16_t*)(p.ws + WS_REGB); bf16_t* mixcat = (bf16_t*)(p.ws + WS_REGC);
    constexpr int BUFB = 57344;
    LAS float* red = (LAS float*)(lds + 2 * BUFB + 32768);
    for (int id = blockIdx.x; id < 256; id += gridDim.x) {
        const int b = id >> 7, h = (id >> 4) & 7, kh = h >> 1, n0 = (id & 15) * 16;
        const unsigned char* hrec0 = gd + ((size_t)(b * 8 + h) * 256 + n0) * GD_HREC; const unsigned char* krec0 = gd + GD_KOFF + ((size_t)(b * 4 + kh) * 256 + n0) * GD_KREC;
        const float* Gc0 = (const float*)(gd + GD_GOFF) + ((size_t)(b * 8 + h) * 256 + n0) * 64;
        const f32x4* sin = (const f32x4*)(p.ws + WS_SIN + (size_t)id * 65536);
        const float nw = p.norm_w[16 * wid + m16];
#define GD_DMA(nn, bufi) do { const unsigned char* _hr = hrec0 + (size_t)(nn) * GD_HREC; const unsigned char* _kr = krec0 + (size_t)(nn) * GD_KREC; \
        _Pragma("unroll") for (int _k = 0; _k < 7; ++_k) { const int _pc = wid + 8 * _k; const unsigned char* _src = (_pc < 24 ? _hr + _pc * 1024 : _kr + (_pc - 24) * 1024) + lane * 16; \
            __builtin_amdgcn_global_load_lds((const unsigned*)_src, (LAS unsigned*)(lds + (bufi) * BUFB + _pc * 1024), 16, 0, 0); } } while (0)
        f32x4 S[8];
#pragma unroll
        for (int a = 0; a < 8; ++a) S[a] = sin[(wid * 8 + a) * 64 + lane];
#define GZ_DMA(nn) do { const size_t _tb = (size_t)b * SEQ + (size_t)(n0 + (nn)) * 64; LAS unsigned char* _zb = lds + 2 * BUFB + ((nn) & 1) * 16384; \
        _Pragma("unroll") for (int _k2 = 0; _k2 < 2; ++_k2) { const int _pc = wid + 8 * _k2; \
            __builtin_amdgcn_global_load_lds((const unsigned*)(proj + (_tb + 4 * _pc + (lane >> 4)) * NPROJ + 5120 + h * 128 + (lane & 15) * 8), (LAS unsigned*)(_zb + _pc * 1024), 16, 0, 0); } } while (0)
        GD_DMA(0, 0); GD_DMA(1, 1); GZ_DMA(0);
        u32x4 ua = *(const u32x4*)(hrec0 + 24576 + (size_t)(wid * 64 + lane) * 32), ub = *(const u32x4*)(hrec0 + 24576 + (size_t)(wid * 64 + lane) * 32 + 16);
        f32x4 gv[4]; float G63 = Gc0[63];
#pragma unroll
        for (int rt = 0; rt < 4; ++rt) gv[rt] = *(const f32x4*)(Gc0 + 16 * rt + 4 * q4);
        asm volatile("s_waitcnt vmcnt(0)" ::: "memory"); __syncthreads();
        for (int n = 0; n < 16; ++n) {
            const int cur = n & 1, nn = (n + 1 < 16) ? n + 1 : n;
            const unsigned char* hrn = hrec0 + (size_t)nn * GD_HREC; const float* Gn = Gc0 + (size_t)nn * 64;
            const u32x4 ua_n = *(const u32x4*)(hrn + 24576 + (size_t)(wid * 64 + lane) * 32), ub_n = *(const u32x4*)(hrn + 24576 + (size_t)(wid * 64 + lane) * 32 + 16);
            f32x4 gv_n[4]; const float G63_n = Gn[63];
#pragma unroll
            for (int rt = 0; rt < 4; ++rt) gv_n[rt] = *(const f32x4*)(Gn + 16 * rt + 4 * q4);
            const size_t tbase = (size_t)b * SEQ + (size_t)(n0 + n) * 64;
            LAS unsigned char* zb = lds + 2 * BUFB + cur * 16384;
            const LAS unsigned char* WN = lds + cur * BUFB; const LAS unsigned char* AT = WN + 16384; const LAS unsigned char* QI = WN + 24576; const LAS unsigned char* KT = WN + 40960;
            f32x4 eg[4], ek[4];
#pragma unroll
            for (int rt = 0; rt < 4; ++rt) {
#pragma unroll
                for (int r = 0; r < 4; ++r) { eg[rt][r] = __expf(gv[rt][r]); ek[rt][r] = __expf(G63 - gv[rt][r]); } }
            const float gam = __expf(G63);
            bf16x8 SB[4];
#pragma unroll
            for (int s = 0; s < 4; ++s) SB[s] = pack8(S[2 * s], S[2 * s + 1]);
            f32x4 av[4]; GD_UNPACK_U(av, ua, ub);
#pragma unroll
            for (int rt = 0; rt < 4; ++rt)
#pragma unroll
                for (int s = 0; s < 4; ++s) av[rt] = __builtin_amdgcn_mfma_f32_16x16x32_bf16(frag256(WN, 16 * rt + m16, 4 * s + q4), SB[s], av[rt], 0, 0, 0);
            bf16x8 VB[2], VBs[2];
#pragma unroll
            for (int s2 = 0; s2 < 2; ++s2) { VB[s2] = pack8(av[2 * s2], av[2 * s2 + 1]); VBs[s2] = pack8(av[2 * s2] * ek[2 * s2], av[2 * s2 + 1] * ek[2 * s2 + 1]); }
            f32x4 ov[4];
#pragma unroll
            for (int rt = 0; rt < 4; ++rt) { f32x4 o1 = (f32x4){0.f, 0.f, 0.f, 0.f}, o2 = (f32x4){0.f, 0.f, 0.f, 0.f};
#pragma unroll
                for (int s = 0; s < 4; ++s) o1 = __builtin_amdgcn_mfma_f32_16x16x32_bf16(frag256(QI, 16 * rt + m16, 4 * s + q4), SB[s], o1, 0, 0, 0);
#pragma unroll
                for (int s2 = 0; s2 < 2; ++s2) o2 = __builtin_amdgcn_mfma_f32_16x16x32_bf16(frag128(AT, 16 * rt + m16, 4 * s2 + q4), VB[s2], o2, 0, 0, 0);
                ov[rt] = o1 * eg[rt] + o2; }
#pragma unroll
            for (int a = 0; a < 8; ++a) { S[a] = S[a] * gam;
#pragma unroll
                for (int s2 = 0; s2 < 2; ++s2) S[a] = __builtin_amdgcn_mfma_f32_16x16x32_bf16(frag128(KT, 16 * a + m16, 4 * s2 + q4), VBs[s2], S[a], 0, 0, 0); }
#pragma unroll
            for (int rt = 0; rt < 4; ++rt)
#pragma unroll
                for (int r = 0; r < 4; ++r) { const float ss = dpp_row_sum(ov[rt][r] * ov[rt][r]); if (m16 == 0) red[(16 * rt + 4 * q4 + r) * 8 + wid] = ss; }
            asm volatile("s_waitcnt vmcnt(0) lgkmcnt(0)" ::: "memory");
            __builtin_amdgcn_s_barrier();
            if (n + 2 < 16) GD_DMA(n + 2, cur);
            if (n + 1 < 16) GZ_DMA(n + 1);
#pragma unroll
            for (int rt = 0; rt < 4; ++rt)
#pragma unroll
                for (int r = 0; r < 4; ++r) { const int tk = 16 * rt + 4 * q4 + r; const f32x4 p0 = *(const LAS f32x4*)(red + tk * 8), p1 = *(const LAS f32x4*)(red + tk * 8 + 4);
                    const float ms = ((p0[0] + p0[1]) + (p0[2] + p0[3]) + (p1[0] + p1[1]) + (p1[2] + p1[3])) * (1.0f / 128.0f);
                    LAS bf16_t* zp = (LAS bf16_t*)(zb + tk * 256 + (16 * wid + m16) * 2);
                    const float zf = __uint_as_float(((unsigned)*zp) << 16);
                    const float y = ov[rt][r] * rsqrtf(ms + 1e-6f) * nw * silu_f(zf);
                    *zp = (bf16_t)(cvt_pk_bf16(y, 0.f) & 0xffffu); }
            asm volatile("s_waitcnt lgkmcnt(0)" ::: "memory");
            __builtin_amdgcn_s_barrier();
            { const int tok = tid >> 3, part = tid & 7;
                const u32x4 y0 = *(const LAS u32x4*)(zb + tok * 256 + part * 32), y1 = *(const LAS u32x4*)(zb + tok * 256 + part * 32 + 16);
                bf16_t* dst = mixcat + (tbase + tok) * DM + 1024 + h * 128 + part * 16;
                *(u32x4*)dst = y0; *(u32x4*)(dst + 8) = y1; }
            ua = ua_n; ub = ub_n; G63 = G63_n;
#pragma unroll
            for (int rt = 0; rt < 4; ++rt) gv[rt] = gv_n[rt];
        }
        asm volatile("s_waitcnt vmcnt(0)" ::: "memory"); __syncthreads();
#undef GD_DMA
#undef GZ_DMA
    }
}


__device__ __forceinline__ void ph_wr_frag(const Params& p) {
    const int tid = otid();
    for (int it = blockIdx.x * NTHR + tid; it < 64 * 5 * 2 * 64; it += gridDim.x * NTHR) {
        const int lane = it & 63, part = (it >> 6) & 1, sc = it >> 7, ct = sc % 5, s = sc / 5;
        const int c = 16 * ct + (lane & 15), k0 = 32 * s + 8 * (lane >> 4);
        float w[8];
#pragma unroll
        for (int j = 0; j < 8; ++j) { const int k = k0 + j; w[j] = c < 8 ? p.w_group[k * 8 + c] : (c < 72 ? p.w_router[k * 64 + (c - 8)] : 0.f); }
        { float sg = 0.f, sb = 0.f;
#pragma unroll
          for (int j = 0; j < 8; ++j) { sb += p.ln2_b[k0 + j] * w[j]; w[j] *= p.ln2_g[k0 + j]; sg += w[j]; }
          (void)sg; (void)sb; }
        unsigned hw[4];
#pragma unroll
        for (int j = 0; j < 4; ++j) hw[j] = cvt_pk_bf16(w[2 * j], w[2 * j + 1]);
        u32x4 o;
        if (part == 0) { o.x = hw[0]; o.y = hw[1]; o.z = hw[2]; o.w = hw[3]; }
        else { o.x = cvt_pk_bf16(w[0] - bflo(hw[0]), w[1] - bfhi(hw[0])); o.y = cvt_pk_bf16(w[2] - bflo(hw[1]), w[3] - bfhi(hw[1]));
               o.z = cvt_pk_bf16(w[4] - bflo(hw[2]), w[5] - bfhi(hw[2])); o.w = cvt_pk_bf16(w[6] - bflo(hw[3]), w[7] - bfhi(hw[3])); }
        *(u32x4*)(p.ws + WS_WRF + (size_t)it * 16) = o;
    }
}
__device__ __forceinline__ void ph_ln2_router(const Params& p, LAS unsigned char* lds) {
    const int tid = otid(), wid = __builtin_amdgcn_readfirstlane(tid >> 6), lane = tid & 63, m16 = lane & 15, q4 = lane >> 4;
    const bf16_t* s2 = (const bf16_t*)(p.ws + WS_S2); float* stats2 = (float*)(p.ws + WS_STATS2);
    const unsigned char* wrf = p.ws + WS_WRF; const float* part2 = (const float*)(p.ws + WS_PART2); const float* GR = (const float*)(p.ws + WS_CTL + CTL_GR); const float* BR = (const float*)(p.ws + WS_CTL + CTL_BR);
    float* gates = (float*)(p.ws + WS_GATES); int* slot = (int*)(p.ws + WS_SLOT); int* counts = (int*)(p.ws + WS_CTL + CTL_COUNTS);
    constexpr int CHB = 40960;
    LAS int* lcnt = (LAS int*)(lds + 2 * CHB + 8 * 5632); LAS int* lbase = lcnt + NEXP;
    if (tid < NEXP) lcnt[tid] = 0;
    __syncthreads();
#define RT_DMA(ch, bufi) do { _Pragma("unroll") for (int _k = 0; _k < 5; ++_k) { const int _pc = wid + 8 * _k; \
        __builtin_amdgcn_global_load_lds((const unsigned*)(wrf + (size_t)(ch) * CHB + _pc * 1024 + lane * 16), (LAS unsigned*)(lds + (bufi) * CHB + _pc * 1024), 16, 0, 0); } } while (0)
    for (int blk = blockIdx.x; blk < T_TOK / 128; blk += gridDim.x) {
        const int row0 = blk * 128 + wid * 16;
        float m2 = 0.f, r2 = 0.f;
#pragma unroll 4
        for (int i = 0; i < 16; ++i) { const f32x2 pp = *(const f32x2*)(part2 + ((size_t)(row0 + i) * 32 + (lane & 31)) * 2); const float ss = wave_sum(lane < 32 ? pp.x : 0.f), qq = wave_sum(lane < 32 ? pp.y : 0.f);
            const float mm = ss * (1.0f / DM), rr = rsqrtf(fmaxf(qq * (1.0f / DM) - mm * mm, 0.f) + 1e-5f); if (lane == i) { m2 = mm; r2 = rr; } }
        if (lane < 16) *(f32x2*)(stats2 + (size_t)(row0 + lane) * 2) = (f32x2){m2, r2};
        m2 = __int_as_float(__builtin_amdgcn_ds_bpermute(m16 * 4, __float_as_int(m2))); r2 = __int_as_float(__builtin_amdgcn_ds_bpermute(m16 * 4, __float_as_int(r2)));
        RT_DMA(0, 0);
        f32x4 acc[5];
#pragma unroll
        for (int ct = 0; ct < 5; ++ct) acc[ct] = (f32x4){0.f, 0.f, 0.f, 0.f};
        const bf16_t* arow = s2 + (size_t)(row0 + m16) * DM + 8 * q4;
        bf16x8 an[4];
#pragma unroll
        for (int ks = 0; ks < 4; ++ks) an[ks] = *(const bf16x8*)(arow + 32 * ks);
        asm volatile("s_waitcnt vmcnt(0)" ::: "memory"); __syncthreads();
        for (int ch = 0; ch < 16; ++ch) {
            if (ch + 1 < 16) RT_DMA(ch + 1, (ch + 1) & 1);
            const LAS unsigned char* wb = lds + (ch & 1) * CHB;
            bf16x8 a[4];
#pragma unroll
            for (int ks = 0; ks < 4; ++ks) a[ks] = an[ks];
            if (ch + 1 < 16) {
#pragma unroll
                for (int ks = 0; ks < 4; ++ks) an[ks] = *(const bf16x8*)(arow + 32 * ((ch + 1) * 4 + ks)); }
#pragma unroll
            for (int ks = 0; ks < 4; ++ks) {
#pragma unroll
                for (int ct = 0; ct < 5; ++ct) { const bf16x8 Whi = *(const LAS bf16x8*)(wb + ((ks * 5 + ct) * 2 + 0) * 1024 + lane * 16), Wlo = *(const LAS bf16x8*)(wb + ((ks * 5 + ct) * 2 + 1) * 1024 + lane * 16);
                    acc[ct] = __builtin_amdgcn_mfma_f32_16x16x32_bf16(Whi, a[ks], acc[ct], 0, 0, 0);
                    acc[ct] = __builtin_amdgcn_mfma_f32_16x16x32_bf16(Wlo, a[ks], acc[ct], 0, 0, 0); } }
            asm volatile("s_waitcnt vmcnt(0)" ::: "memory"); __syncthreads();
        }
        LAS float* tl = (LAS float*)(lds + 2 * CHB + wid * 5632);
#pragma unroll
        for (int ct = 0; ct < 5; ++ct) { const f32x4 gr = *(const f32x4*)(GR + 16 * ct + 4 * q4), br = *(const f32x4*)(BR + 16 * ct + 4 * q4);
            *(LAS f32x4*)(tl + m16 * 88 + 16 * ct + 4 * q4) = (acc[ct] - gr * m2) * r2 + br; }
        asm volatile("s_waitcnt lgkmcnt(0)" ::: "memory");
        int ex0 = 0, ex1 = 0, lp0 = 0, lp1 = 0;
        if (lane < 16) { const int t = row0 + lane; const LAS float* l = tl + lane * 88;
            int g = 0; float gm = l[0];
            for (int i = 1; i < 8; ++i) { const float x = l[i]; if (x > gm) { gm = x; g = i; } }
            float gs = 0.f; for (int i = 0; i < 8; ++i) gs += __expf(l[i] - gm);
            const float gprob = 1.0f / gs;
            const LAS float* el = l + 8 + g * 8;
            int i0 = 0; float m0 = el[0];
            for (int i = 1; i < 8; ++i) { const float x = el[i]; if (x > m0) { m0 = x; i0 = i; } }
            int i1 = -1; float m1 = -3.0e38f;
            for (int i = 0; i < 8; ++i) { const float x = el[i]; if (i != i0 && x > m1) { m1 = x; i1 = i; } }
            const float e1 = __expf(m1 - m0), den = 1.0f + e1;
            gates[t * 2] = gprob / den; gates[t * 2 + 1] = gprob * e1 / den;
            ex0 = g * 8 + i0; ex1 = g * 8 + i1;
            lp0 = atomicAdd((int*)&lcnt[ex0], 1); lp1 = atomicAdd((int*)&lcnt[ex1], 1); }
        __syncthreads();
        if (tid < NEXP) { const int n = lcnt[tid]; lbase[tid] = n ? atomicAdd(&counts[tid], n) : 0; }
        __syncthreads();
        if (lane < 16) { const int t = row0 + lane; slot[(size_t)ex0 * CAP + lbase[ex0] + lp0] = 2 * t; slot[(size_t)ex1 * CAP + lbase[ex1] + lp1] = 2 * t + 1; }
        __syncthreads();
        if (tid < NEXP) lcnt[tid] = 0;
        __syncthreads();
    }
#undef RT_DMA
}

__device__ __forceinline__ void ph_gnorm(const Params& p) {
    const float* of = (const float*)(p.ws + WS_REGA); const bf16_t* proj = (const bf16_t*)(p.ws + WS_REGB); bf16_t* mixcat = (bf16_t*)(p.ws + WS_REGC);
    const int tid = otid(), lane = tid & 63, wv = blockIdx.x * 8 + (tid >> 6), nw = gridDim.x * 8;
    for (int i = wv; i < T_TOK * 8; i += nw) { const int t = i >> 3, h = i & 7;
        const f32x2 o = *(const f32x2*)(of + (size_t)t * 1024 + h * 128 + lane * 2);
        const float ms = wave_sum(o.x * o.x + o.y * o.y) * (1.0f / 128.0f), r = rsqrtf(ms + 1e-6f);
        const unsigned zw = *(const unsigned*)(proj + (size_t)t * NPROJ + 5120 + h * 128 + lane * 2);
        const float y0 = o.x * r * p.norm_w[lane * 2] * silu_f(bflo(zw)), y1 = o.y * r * p.norm_w[lane * 2 + 1] * silu_f(bfhi(zw));
        *(unsigned*)(mixcat + (size_t)t * DM + 1024 + h * 128 + lane * 2) = cvt_pk_bf16(y0, y1); }
}

__device__ __forceinline__ void ph_grbr(const Params& p) {
    const int c = blockIdx.x; if (c >= 72) return;
    const int tid = otid(), wid = tid >> 6, lane = tid & 63, k0 = wid * 256 + lane * 4;
    const f32x4 g = *(const f32x4*)(p.ln2_g + k0), b = *(const f32x4*)(p.ln2_b + k0); float sg = 0.f, sb = 0.f;
#pragma unroll
    for (int i = 0; i < 4; ++i) { const int k = k0 + i; const float w = c < 8 ? p.w_group[k * 8 + c] : p.w_router[k * 64 + (c - 8)]; sg += g[i] * w; sb += b[i] * w; }
    sg = wave_sum(sg); sb = wave_sum(sb);
    if (lane == 0) { atomicAdd((float*)(p.ws + WS_CTL + CTL_GR) + c, sg); atomicAdd((float*)(p.ws + WS_CTL + CTL_BR) + c, sb); }
}
__device__ __forceinline__ void ph_wq2(const Params& p) {
    const int tid = otid(); bf16_t* wq2 = (bf16_t*)(p.ws + WS_WQ2); float* G1 = (float*)(p.ws + WS_CTL + CTL_G1); float* B1 = (float*)(p.ws + WS_CTL + CTL_B1);
    for (int blk = blockIdx.x; blk < DM / 8; blk += gridDim.x) { f32x4 sg = (f32x4){0.f, 0.f, 0.f, 0.f}, sb = (f32x4){0.f, 0.f, 0.f, 0.f};
#pragma unroll
        for (int i = 0; i < 8; ++i) { const int k = blk * 8 + i; const float g = p.ln1_g[k], b = p.ln1_b[k]; const f32x4 w = *(const f32x4*)(p.wq + (size_t)k * DM + tid * 4);
            const f32x4 wg = w * g; sg += wg; sb += w * b;
            u32x2 o; o.x = cvt_pk_bf16(wg[0], wg[1]); o.y = cvt_pk_bf16(wg[2], wg[3]); *(u32x2*)(wq2 + (size_t)k * DM + tid * 4) = o; }
#pragma unroll
        for (int j = 0; j < 4; ++j) { atomicAdd(G1 + tid * 4 + j, sg[j]); atomicAdd(B1 + tid * 4 + j, sb[j]); } }
}
__device__ __forceinline__ void ph_gkbk(const Params& p, int rank) {
    const int tid = otid(), wid = tid >> 6, lane = tid & 63; const bf16_t* kx = (const bf16_t*)(p.ws + WS_KX); const float* G1 = (const float*)(p.ws + WS_CTL + CTL_G1); const float* B1 = (const float*)(p.ws + WS_CTL + CTL_B1);
    float* GK = (float*)(p.ws + WS_CTL + CTL_GK); float* BK = (float*)(p.ws + WS_CTL + CTL_BK);
#pragma unroll
    for (int i = 0; i < 2; ++i) { const int o = rank * 16 + wid * 2 + i, b = o >> 10, h = (o >> 8) & 3, m = o & 255;
        const u32x4 w = *(const u32x4*)(kx + (size_t)(b * 256 + m) * DM + h * 512 + lane * 8); float x[8]; unpack8(w, x);
        const f32x4 g0 = *(const f32x4*)(G1 + h * 512 + lane * 8), g1 = *(const f32x4*)(G1 + h * 512 + lane * 8 + 4), b0 = *(const f32x4*)(B1 + h * 512 + lane * 8), b1 = *(const f32x4*)(B1 + h * 512 + lane * 8 + 4);
        float sg = (x[0] * g0[0] + x[1] * g0[1]) + (x[2] * g0[2] + x[3] * g0[3]) + (x[4] * g1[0] + x[5] * g1[1]) + (x[6] * g1[2] + x[7] * g1[3]);
        float sb = (x[0] * b0[0] + x[1] * b0[1]) + (x[2] * b0[2] + x[3] * b0[3]) + (x[4] * b1[0] + x[5] * b1[1]) + (x[6] * b1[2] + x[7] * b1[3]);
        sg = wave_sum(sg); sb = wave_sum(sb);
        if (lane == 0) { GK[o] = sg; BK[o] = sb; } }
}

extern __shared__ __attribute__((aligned(16))) unsigned char dynlds[];
__device__ __forceinline__ void moe_tables(const Params& p, LAS unsigned char* xl) {
    LAS int* ct = (LAS int*)(xl + 8192); LAS int* cnt = (LAS int*)(xl + 8192 + 512);
    const int* counts = (const int*)(p.ws + WS_CTL + CTL_COUNTS);
    const int tid = otid();
    if (tid < NEXP) cnt[tid] = __hip_atomic_load(counts + tid, __ATOMIC_RELAXED, __HIP_MEMORY_SCOPE_AGENT);
    __syncthreads();
    if (tid == 0) { int s = 0; for (int e = 0; e < NEXP; ++e) { ct[e] = s; s += (cnt[e] + 255) >> 8; } ct[NEXP] = s;
        LAS int* tl = (LAS int*)(xl + 8192 + 1024) + 1; const int x = blockIdx.x & 7; int nt_ = 0;
        for (int pass = 0; pass < 2; ++pass) for (int k = 0; k < 8; ++k) { const int e = x + 8 * k, n = cnt[e], nt = (n + 255) >> 8, nl = (nt > 0 && (n - (nt - 1) * 256) <= 128) ? 1 : 0;
            if (pass == 0) { for (int j = 0; j < nt - nl; ++j) tl[nt_++] = e | (j << 8); } else if (nl) tl[nt_++] = e | ((nt - 1) << 8) | (1 << 16); }
        tl[-1] = nt_; }
    __syncthreads();
}
#ifndef DUP_MASK
#define DUP_MASK 0
#endif
#define DUP_N 1
template <int N, class F> __device__ __forceinline__ void repeat_n(const F& f) { if constexpr (N > 0) { f(); repeat_n<N - 1>(f); } }
#define PH(bit, ...) { __VA_ARGS__; xcd_barrier(bar); } if constexpr (((DUP_MASK) >> (bit)) & 1) { repeat_n<DUP_N>([&]() { __VA_ARGS__; xcd_barrier(bar); }); }
__global__ __launch_bounds__(NTHR, 2) void k_mega(Params p) {
    LAS unsigned char* lds = (LAS unsigned char*)dynlds; LAS unsigned char* xl = lds + XL_OFF;
    const int G = gridDim.x, c = blockIdx.x;
    volatile LAS unsigned* xbw = (volatile LAS unsigned*)(lds + LDS_BYTES - 16);
    if (threadIdx.x == 0) { xbw[0] = 0u; xbw[1] = 0u; xbw[2] = 0u; xbw[3] = 0u; }
    __syncthreads();
    const XcdBarrier bar = xcd_barrier_post((unsigned*)(p.ws + WS_CTL), xbw);
    if constexpr (((DUP_MASK) >> 15) & 1) { repeat_n<DUP_N>([&]() { ph_ln0(p, lds); __syncthreads(); }); }
    if constexpr (((DUP_MASK) >> 16) & 1) { repeat_n<DUP_N>([&]() { ph_wr_frag(p); ph_transpose(p, lds, 0, TR_SMALL, blockIdx.x, gridDim.x); }); }
    PH(0, ph_ln0(p, lds); __syncthreads(); ph_wr_frag(p); ph_grbr(p); ph_wq2(p); ph_transpose(p, lds, 0, TR_SMALL, blockIdx.x, gridDim.x))
    PH(1, { pg8::PlainSched S; S.init(p.ws + WS_REGA, p.ws + WS_WINT, T_TOK, NPROJ, DM, DM, G, c); pg8::EpiBf16 E{(bf16_t*)(p.ws + WS_REGB), NPROJ}; pg8::gemm_phase<pg8::EpiBf16, pg8::PlainSched, false>(lds, xl, DM, DM, DM, S, E); })
    PH(3, ph_gdn_prep(p, lds))
    PH(4, ph_gdn_passA(p, lds))
    PH(5, if (blockIdx.x < 16) { ph_gdn_combine(p, lds);
              { pg8::PlainSched S; S.init(p.ws + WS_MEMB, p.ws + WS_WKT, 512, DM, DM, DM, 16, c); pg8::EpiBf16 E{(bf16_t*)(p.ws + WS_KX), DM}; pg8::gemm_phase<pg8::EpiBf16, pg8::PlainSched, false>(lds, xl, DM, DM, DM, S, E); }
              { pg8::PlainSched S; S.init(p.ws + WS_MEMB, p.ws + WS_WVT, 512, DM, DM, DM, 16, c); pg8::EpiBf16 E{(bf16_t*)(p.ws + WS_VT), DM}; pg8::gemm_phase<pg8::EpiBf16, pg8::PlainSched, false>(lds, xl, DM, DM, DM, S, E); } }
          ph_transpose_experts(p, lds, xl))
    PH(6, ph_gdn_passB(p, lds))
    PH(7, { pg8::PlainSched S; S.init(p.ws + WS_REGC, p.ws + WS_WOUTT, T_TOK, DM, DM, DM, G, c); pg8::EpiResid1 E{(bf16_t*)(p.ws + WS_REGB), (const bf16_t*)(p.ws + WS_REGA), (float*)(p.ws + WS_PART1)};
            pg8::gemm_phase<pg8::EpiResid1, pg8::PlainSched, false>(lds, xl, DM, DM, DM, S, E); }
          { pg8::MNSched S{(const char*)(p.ws + WS_KX), (const char*)(p.ws + WS_VT), (const char*)(p.ws + WS_WQ2), (const char*)(p.ws + WS_WOT), c, 0}; pg8::EpiBf16 E{(bf16_t*)(p.ws + WS_MT), DM};
            pg8::gemm_phase<pg8::EpiBf16, pg8::MNSched, false>(lds, xl, DM, DM, 512, S, E); }
          { pg8::MNSched S{(const char*)(p.ws + WS_KX), (const char*)(p.ws + WS_VT), (const char*)(p.ws + WS_WQ2), (const char*)(p.ws + WS_WOT), c, 1}; pg8::EpiBf16 E{(bf16_t*)(p.ws + WS_NT), 1024};
            pg8::gemm_phase<pg8::EpiBf16, pg8::MNSched, false>(lds, xl, DM, DM, 512, S, E); }
          if (c >= 128) ph_gkbk(p, c - 128))
    PH(9, { pg8::AttnS2Sched S{(const char*)(p.ws + WS_REGB), (const char*)(p.ws + WS_MT), G, c};
            pg8::EpiSoftmax2 E{(bf16_t*)(p.ws + WS_REGC), 0.044194173824159216f * 1.4426950408889634f, (const float*)(p.ws + WS_PART1), (const float*)(p.ws + WS_CTL + CTL_GK), (const float*)(p.ws + WS_CTL + CTL_BK), (float*)(p.ws + WS_STATS1)};
            pg8::gemm_phase<pg8::EpiSoftmax2, pg8::AttnS2Sched, false>(lds, xl, DM, DM, DM, S, E); })
    PH(10, { pg8::AttnO2Sched S{(const char*)(p.ws + WS_REGC), (const char*)(p.ws + WS_NT), 1024, G, c}; pg8::EpiResid2 E{(bf16_t*)(p.ws + WS_S2), (const bf16_t*)(p.ws + WS_REGB), (const float*)(p.ws + WS_STATS1), (float*)(p.ws + WS_PART2), p.ln1_g, p.ln1_b};
             pg8::gemm_phase<pg8::EpiResid2, pg8::AttnO2Sched, false>(lds, xl, 1024, 1024, 1024, S, E); })
    { ph_ln2_router(p, lds); xcd_barrier(bar); }
    moe_tables(p, xl);
    PH(13, { pg8::MoeSched S{(const LAS int*)(xl + 8192), (const LAS int*)(xl + 8192 + 512), 4, G, c, 0, p.ws, (const LAS int*)(xl + 8192 + 1024) + 1};
             pg8::EpiSwiGLU E{(bf16_t*)(p.ws + WS_REGA), p.ws, (const LAS int*)(xl + 8192 + 512)}; pg8::gemm_phase<pg8::EpiSwiGLU, pg8::MoeSched, true, true>(lds, xl, DM, DM, DM, S, E); })
    PH(14, { pg8::MoeSched S{(const LAS int*)(xl + 8192), (const LAS int*)(xl + 8192 + 512), 8, G, c, 1, p.ws, (const LAS int*)(xl + 8192 + 1024) + 1};
             pg8::EpiScatter E{(bf16_t*)p.out, (const int*)(p.ws + WS_SLOT), (const LAS int*)(xl + 8192 + 512)}; pg8::gemm_phase<pg8::EpiScatter, pg8::MoeSched, false, true>(lds, xl, 512, 512, 512, S, E); })
    ph_ln3(p);
}

extern "C" void kernel_launch(void* const* d_in, const int* in_sizes, int n_in, void* d_out, int out_size, void* d_ws, size_t ws_size, hipStream_t stream) {
    static int grid = 0;
    if (grid == 0) {
        if (n_in != 26 || in_sizes[0] != T_TOK * DM || out_size != T_TOK * DM || ws_size < WS_END) {
            fprintf(stderr, "kernel_launch: unexpected shapes: n_in %d in0 %d out %d ws %zu (need %zu); nothing launched\n", n_in, n_in > 0 ? in_sizes[0] : -1, out_size, ws_size, (size_t)WS_END); grid = -1; return; }
        int dev = 0, cus = 0, per_cu = 0;
        if (hipGetDevice(&dev) != hipSuccess || hipDeviceGetAttribute(&cus, hipDeviceAttributeMultiprocessorCount, dev) != hipSuccess) { grid = -1; return; }
        if (hipFuncSetAttribute((const void*)k_mega, hipFuncAttributeMaxDynamicSharedMemorySize, LDS_BYTES) != hipSuccess) { fprintf(stderr, "kernel_launch: hipFuncSetAttribute failed\n"); grid = -1; return; }
        if (hipOccupancyMaxActiveBlocksPerMultiprocessor(&per_cu, (const void*)k_mega, NTHR, LDS_BYTES) != hipSuccess || per_cu < 1) fprintf(stderr, "kernel_launch: occupancy query says %d\n", per_cu);
        (void)hipGetLastError();
        grid = cus;
    }
    if (grid < 0) return;
    (void)hipMemsetAsync((char*)d_ws + WS_CTL, 0, CTL_BYTES, stream);
    Params p{};
    const float** pp = (const float**)&p;
    for (int i = 0; i < 26; ++i) pp[i] = (const float*)d_in[i];
    p.out = (float*)d_out; p.ws = (unsigned char*)d_ws;
    hipLaunchKernelGGL(k_mega, dim3(grid), dim3(NTHR), LDS_BYTES, stream, p);
}
```

```cpp
#include <hip/hip_runtime.h>
#include <cstdio>
#include <cstdint>

#define LAS __attribute__((address_space(3)))
typedef unsigned short bf16_t;
typedef short bf16x8 __attribute__((ext_vector_type(8)));
typedef float f32x4 __attribute__((ext_vector_type(4)));
typedef float f32x2 __attribute__((ext_vector_type(2)));
typedef unsigned u32x4 __attribute__((ext_vector_type(4)));
typedef unsigned u32x2 __attribute__((ext_vector_type(2)));

constexpr int T_TOK = 32768, DM = 2048, SEQ = 16384;
constexpr int NPROJ = 6144, NIN = 6160;
constexpr int NEXP = 64, CAP = 32768;
constexpr float ALPHA = 1.189207115002721f;
constexpr int NTHR = 512;
constexpr int LDS_BYTES = 155648;
constexpr int XL_OFF = 131072;

constexpr size_t MiB = 1048576;
constexpr size_t WS_CTL = 0, CTL_BYTES = 65536, CTL_COUNTS = 16384;
constexpr size_t WS_WINT = WS_CTL + CTL_BYTES;
constexpr size_t WS_WOUTT = WS_WINT + (size_t)NPROJ * DM * 2;
constexpr size_t WS_WQT = WS_WOUTT + 8 * MiB, WS_WKT = WS_WQT + 8 * MiB, WS_WVT = WS_WKT + 8 * MiB, WS_WOT = WS_WVT + 8 * MiB;
constexpr size_t WS_W13T = WS_WOT + 8 * MiB;
constexpr size_t WS_W2T = WS_W13T + 256 * MiB;
constexpr size_t WS_REGA = WS_W2T + 128 * MiB;
constexpr size_t WS_REGB = WS_REGA + 128 * MiB;
constexpr size_t WS_REGC = WS_REGB + 384 * MiB;
constexpr size_t WS_STATS0 = WS_REGC + 128 * MiB;
constexpr size_t WS_AB = WS_STATS0 + (size_t)T_TOK * 8;
constexpr size_t WS_GG = WS_AB + (size_t)T_TOK * 64;
constexpr size_t WS_GB = WS_GG + (size_t)T_TOK * 32;
constexpr size_t WS_MEMB = WS_GB + (size_t)T_TOK * 32;
constexpr size_t WS_KX = WS_MEMB + 2 * MiB;
constexpr size_t WS_VT = WS_KX + 2 * MiB;
constexpr size_t WS_GATES = WS_VT + 2 * MiB;
constexpr size_t WS_SLOT = WS_GATES + (size_t)T_TOK * 8;
constexpr size_t WS_WRF = WS_SLOT + (size_t)NEXP * CAP * 4;
constexpr size_t WS_PART1 = WS_WRF + 655360;
constexpr size_t WS_SIN = WS_PART1 + (size_t)T_TOK * 32 * 8;
constexpr size_t WS_WQ2 = WS_SIN + 16 * MiB;
constexpr size_t WS_G13 = WS_WQ2 + 8 * MiB;
constexpr size_t WS_B13 = WS_G13 + 262144;
constexpr size_t WS_STATS2 = WS_B13 + 262144;
constexpr size_t WS_STATS1 = WS_STATS2 + (size_t)T_TOK * 8;
constexpr size_t WS_END = WS_STATS1 + (size_t)T_TOK * 8;
constexpr size_t WS_PART2 = WS_WQT;
constexpr size_t WS_S2 = WS_REGB + 256 * MiB;
constexpr size_t CTL_TRQ = 54272;
constexpr size_t CTL_GR = 53248, CTL_BR = 53760;
constexpr size_t WS_MT = WS_REGB + 128 * MiB, WS_NT = WS_REGB + 136 * MiB;
constexpr size_t CTL_GK = 36864, CTL_BK = 45056;
constexpr size_t CTL_G1 = 20480, CTL_B1 = 28672;

struct Params {
    const float *x, *mem, *ln0_g, *ln0_b, *w_in, *sconv_w, *gdn_conv_w, *a_log, *dt_bias, *norm_w, *w_out, *ln1_g, *ln1_b, *wq, *wk, *wv, *wo, *ln2_g, *ln2_b,
        *w_group, *w_router, *w1, *w3, *w2, *ln3_g, *ln3_b;
    float* out; unsigned char* ws;
};

typedef __bf16 bf16x2_t __attribute__((ext_vector_type(2)));
__device__ __forceinline__ unsigned cvt_pk_bf16(float lo, float hi) { const f32x2 v = {lo, hi}; return __builtin_bit_cast(unsigned, __builtin_convertvector(v, bf16x2_t)); }
__device__ __forceinline__ float bflo(unsigned w) { return __uint_as_float(w << 16); }
__device__ __forceinline__ float bfhi(unsigned w) { return __uint_as_float(w & 0xffff0000u); }
__device__ __forceinline__ int otid() { int t = threadIdx.x; asm volatile("" : "+v"(t)); return t; }
__device__ __forceinline__ const unsigned char* opaque_uniform(const unsigned char* p) { unsigned lo = __builtin_amdgcn_readfirstlane((unsigned)(uintptr_t)p), hi = __builtin_amdgcn_readfirstlane((unsigned)((uintptr_t)p >> 32));
    asm volatile("" : "+s"(lo), "+s"(hi)); return (const unsigned char*)(((uintptr_t)hi << 32) | lo); }
__device__ __forceinline__ float dpp_row_sum(float x) {
    x += __int_as_float(__builtin_amdgcn_mov_dpp(__float_as_int(x), 0xB1, 0xF, 0xF, true));
    x += __int_as_float(__builtin_amdgcn_mov_dpp(__float_as_int(x), 0x4E, 0xF, 0xF, true));
    x += __int_as_float(__builtin_amdgcn_mov_dpp(__float_as_int(x), 0x141, 0xF, 0xF, true));
    x += __int_as_float(__builtin_amdgcn_mov_dpp(__float_as_int(x), 0x140, 0xF, 0xF, true));
    return x; }
__device__ __forceinline__ float wave_sum(float v) { v = dpp_row_sum(v); const int b = __float_as_int(v);
    return (__int_as_float(__builtin_amdgcn_readlane(b, 0)) + __int_as_float(__builtin_amdgcn_readlane(b, 16))) + (__int_as_float(__builtin_amdgcn_readlane(b, 32)) + __int_as_float(__builtin_amdgcn_readlane(b, 48))); }
__device__ __forceinline__ float xrow_sum(float v) {
    const auto r = __builtin_amdgcn_permlane16_swap(__float_as_int(v), __float_as_int(v), false, false); const float s = __int_as_float(r[0]) + __int_as_float(r[1]);
    const auto q = __builtin_amdgcn_permlane32_swap(__float_as_int(s), __float_as_int(s), false, false); return __int_as_float(q[0]) + __int_as_float(q[1]); }
__device__ __forceinline__ float xrow_max(float v) {
    const auto r = __builtin_amdgcn_permlane16_swap(__float_as_int(v), __float_as_int(v), false, false); const float s = fmaxf(__int_as_float(r[0]), __int_as_float(r[1]));
    const auto q = __builtin_amdgcn_permlane32_swap(__float_as_int(s), __float_as_int(s), false, false); return fmaxf(__int_as_float(q[0]), __int_as_float(q[1])); }
__device__ __forceinline__ float wave_scan(float x) {
    x += __int_as_float(__builtin_amdgcn_update_dpp(0, __float_as_int(x), 0x111, 0xF, 0xF, false));
    x += __int_as_float(__builtin_amdgcn_update_dpp(0, __float_as_int(x), 0x112, 0xF, 0xF, false));
    x += __int_as_float(__builtin_amdgcn_update_dpp(0, __float_as_int(x), 0x114, 0xF, 0xF, false));
    x += __int_as_float(__builtin_amdgcn_update_dpp(0, __float_as_int(x), 0x118, 0xF, 0xF, false));
    x += __int_as_float(__builtin_amdgcn_update_dpp(0, __float_as_int(x), 0x142, 0xA, 0xF, false));
    x += __int_as_float(__builtin_amdgcn_update_dpp(0, __float_as_int(x), 0x143, 0xC, 0xF, false));
    return x; }
__device__ __forceinline__ float silu_f(float x) { return x / (1.0f + __expf(-x)); }

#define XB_TMO      128
#define XB_XCNT(j)  (256  + 64 * (j))
#define XB_XSUB(j)  (1280 + 64 * (j))
#define XB_XGEN(j)  (2304 + 64 * (j))
#define XB_TOP      3328
#define XB_TOPGEN   3392
#define XCD_BAR_WORDS 3456
#define XB_SPIN_CAP (1u << 18)

__device__ __forceinline__ unsigned xb_ld(unsigned* p)              { return __hip_atomic_load(p, __ATOMIC_RELAXED, __HIP_MEMORY_SCOPE_AGENT); }
__device__ __forceinline__ unsigned xb_add(unsigned* p, unsigned v) { return __hip_atomic_fetch_add(p, v, __ATOMIC_RELAXED, __HIP_MEMORY_SCOPE_AGENT); }
__device__ __forceinline__ unsigned xb_xcc_id() { return (unsigned)__builtin_amdgcn_s_getreg((3 << 11) | 20) & 0xFu; }
#define XB_SPIN(cond, bar) do { unsigned _sp = 0; while (cond) { __builtin_amdgcn_s_sleep(1); \
    if ((++_sp & 255u) == 0u) { if (xb_ld(&(bar)[XB_TMO])) break; if (_sp > XB_SPIN_CAP) { atomicAdd(&(bar)[XB_TMO], 1u); break; } } } } while (0)

struct XcdBarrier {
    unsigned* bar; unsigned x;
    volatile LAS unsigned* st;
};

__device__ __forceinline__ XcdBarrier xcd_barrier_post(unsigned* bar, volatile LAS unsigned* st) {
    XcdBarrier b; b.bar = bar; b.x = xb_xcc_id(); b.st = st;
    if (threadIdx.x == 0) (void)xb_add(&bar[XB_XCNT(b.x)], 1u);
    return b;
}
__device__ __forceinline__ void xcd_barrier_complete(unsigned* bar, unsigned x, unsigned& nloc, unsigned& nx) {
    const unsigned G = gridDim.x * gridDim.y * gridDim.z;
    unsigned sum, cnt, mine, sp = 0u;
    for (;;) {
        sum = 0u; cnt = 0u; mine = 0u;
#pragma unroll
        for (unsigned j = 0; j < 16; ++j) { const unsigned c = xb_ld(&bar[XB_XCNT(j)]); sum += c; cnt += (c > 0u) ? 1u : 0u; mine = (j == x) ? c : mine; }
        if (sum == G) break;
        __builtin_amdgcn_s_sleep(1);
        if ((++sp & 255u) == 0u) { if (xb_ld(&bar[XB_TMO])) break; if (sp > XB_SPIN_CAP) { atomicAdd(&bar[XB_TMO], 1u); break; } }
    }
    nloc = mine > 0u ? mine : 1u; nx = cnt > 0u ? cnt : 1u;
}

__device__ __forceinline__ void xcd_barrier(const XcdBarrier& b) {
    asm volatile("s_waitcnt vmcnt(0)" ::: "memory");
    __syncthreads();
    if (threadIdx.x == 0) {
        unsigned* bar = b.bar;
        __builtin_amdgcn_s_waitcnt(0);
        unsigned nloc = b.st[0], nx = b.st[1];
        if (nloc == 0u) { xcd_barrier_complete(bar, b.x, nloc, nx); b.st[0] = nloc; b.st[1] = nx; }
        const unsigned old = xb_add(&bar[XB_XSUB(b.x)], 1u);
        const unsigned gen = old / nloc;
        if (old + 1u == (gen + 1u) * nloc) {
            __builtin_amdgcn_fence(__ATOMIC_RELEASE, "agent");
            asm volatile("s_waitcnt vmcnt(0)" ::: "memory");
            const unsigned og = xb_add(&bar[XB_TOP], 1u);
            const unsigned tg = og / nx;
            if (og + 1u == (tg + 1u) * nx) xb_add(&bar[XB_TOPGEN], 1u);
            else XB_SPIN(xb_ld(&bar[XB_TOPGEN]) == tg, bar);
            __builtin_amdgcn_fence(__ATOMIC_ACQUIRE, "agent");
            xb_add(&bar[XB_XGEN(b.x)], 1u);
            asm volatile("s_waitcnt vmcnt(0)" ::: "memory");
        } else {
            XB_SPIN(xb_ld(&bar[XB_XGEN(b.x)]) == gen, bar);
            __builtin_amdgcn_fence(__ATOMIC_ACQUIRE, "agent");
            asm volatile("s_waitcnt vmcnt(0)" ::: "memory");
        }
    }
    __syncthreads();
}


namespace pg8 {
constexpr int BM = 256, BK = 64, HALF = 128, HTB = HALF * BK * 2, STAGE_BYTES = 8 * HTB, NXCD = 8, WGM = 4;
__host__ __device__ __forceinline__ int lds_byte(int r, int c) { const int st = (r >> 4) * 2 + (c >> 5), rr = r & 15, cc = c & 31, ob = rr * 64 + cc * 2; return st * 1024 + (ob ^ (((ob >> 9) & 1) << 5)); }
__host__ __device__ __forceinline__ void stage_rc(int b, int& R, int& C) { const int st = b / 1024, sb = b % 1024, swz = sb ^ (((sb >> 9) & 1) << 5); R = (st >> 1) * 16 + swz / 64; C = (st & 1) * 32 + (swz % 64) / 2; }
__host__ __device__ __forceinline__ int perm32(int rho) { const int n = rho >> 4, i = rho & 15; return 8 * (i >> 2) + 4 * n + (i & 3); }

struct GUnit { const char* A; const char* B; int pm, pn, x0, x1; };

typedef f32x4 Acc[2][2][4][2];

template <class Epi, class Sched, bool GATHER, bool LIGHTSKIP = false>
__device__ __forceinline__ void gemm_phase(LAS unsigned char* lds, LAS unsigned char* xl, const int lda, const int ldb, const int K, const Sched& S, const Epi& E) {
    const int tid = otid(), wid = __builtin_amdgcn_readfirstlane(tid >> 6), lane = tid & 63, wr = wid >> 2, wc = wid & 3, fr = lane & 15, fq = lane >> 4;
    const int nt = K / BK;
    int Rr[2], Cc[2]; unsigned voffA[2], voffB[2];
#pragma unroll
    for (int i = 0; i < 2; ++i) { stage_rc(tid * 16 + i * 8192, Rr[i], Cc[i]); const int Rb = Epi::PERM ? ((Rr[i] & ~31) + perm32(Rr[i] & 31)) : Rr[i];
        voffA[i] = (unsigned)(Rr[i] * lda + Cc[i]) * 2u; voffB[i] = (unsigned)(Rb * ldb + Cc[i]) * 2u; }
    unsigned vc[2][2], vn[2][2];
    const size_t kstep = (size_t)(BK * 2);
    const size_t hstepA = (size_t)HALF * lda * 2, hstepB = (size_t)HALF * ldb * 2;
    const unsigned ldsw = (unsigned)wid * 1024u;
    const int aoff = lds_byte(wr * 64 + fr, fq * 8), boff = lds_byte(wc * 32 + fr, fq * 8);
#define PG8_SA(b, h) (((b) * 2 + (h)) * HTB)
#define PG8_SB(b, h) ((4 + (b) * 2 + (h)) * HTB)
#define PG8_STAGE2(bufoff, gbase, o0, o1) do { \
        __builtin_amdgcn_global_load_lds((const unsigned*)((const char*)(gbase) + (o0)), (LAS unsigned*)(lds + (bufoff) + ldsw), 16, 0, 0); \
        __builtin_amdgcn_global_load_lds((const unsigned*)((const char*)(gbase) + (o1)), (LAS unsigned*)(lds + (bufoff) + ldsw + 8192), 16, 0, 0); } while (0)
#define PG8_STAGE_B(b, h, bp) PG8_STAGE2(PG8_SB(b, h), (bp) + (h) * hstepB, voffB[0], voffB[1])
#define PG8_STAGE_A(b, h, ap, NX) do { if constexpr (GATHER) { const unsigned _o0 = (NX) ? vn[h][0] : vc[h][0], _o1 = (NX) ? vn[h][1] : vc[h][1]; PG8_STAGE2(PG8_SA(b, h), (ap), _o0, _o1); } \
        else { PG8_STAGE2(PG8_SA(b, h), (ap) + (h) * hstepA, voffA[0], voffA[1]); } } while (0)
#define PG8_LDA(dst, b, h) do { _Pragma("unroll") for (int m = 0; m < 4; ++m) _Pragma("unroll") for (int k = 0; k < 2; ++k) dst[m][k] = *(const LAS bf16x8*)(lds + PG8_SA(b, h) + aoff + m * 2048 + k * 1024); } while (0)
#define PG8_LDB(dst, b, h) do { _Pragma("unroll") for (int n = 0; n < 2; ++n) _Pragma("unroll") for (int k = 0; k < 2; ++k) dst[n][k] = *(const LAS bf16x8*)(lds + PG8_SB(b, h) + boff + n * 2048 + k * 1024); } while (0)
#define PG8_MMA(ai, bj, At, Bt) do { __builtin_amdgcn_s_setprio(1); _Pragma("unroll") for (int m = 0; m < 4; ++m) _Pragma("unroll") for (int n = 0; n < 2; ++n) _Pragma("unroll") for (int k = 0; k < 2; ++k) \
        acc[ai][bj][m][n] = __builtin_amdgcn_mfma_f32_16x16x32_bf16(Bt[n][k], At[m][k], acc[ai][bj][m][n], 0, 0, 0); __builtin_amdgcn_s_setprio(0); } while (0)
#define PG8_WAIT_V(n) asm volatile("s_waitcnt vmcnt(" #n ")" ::: "memory")
#define PG8_WAIT_L(n) asm volatile("s_waitcnt lgkmcnt(" #n ")" ::: "memory")
#define PG8_BAR __builtin_amdgcn_s_barrier()
#define PG8_SCHED __builtin_amdgcn_sched_barrier(0)
    GUnit cur, nxt; int ui = 0;
    if (!S.next(0, cur)) return;
    Acc acc;
#pragma unroll
    for (int a = 0; a < 2; ++a)
#pragma unroll
        for (int b = 0; b < 2; ++b)
#pragma unroll
            for (int m = 0; m < 4; ++m)
#pragma unroll
                for (int n = 0; n < 2; ++n) acc[a][b][m][n] = (f32x4){0.f, 0.f, 0.f, 0.f};
    bf16x8 At[4][2], B0[2][2], B1[2][2];
    const char* cA = cur.A; const char* cB = cur.B;
    if constexpr (GATHER) { S.offsets(cur, lda, vc);
#pragma unroll
        for (int h = 0; h < 2; ++h) { vn[h][0] = vc[h][0]; vn[h][1] = vc[h][1]; } }
    PG8_STAGE_B(0, 0, cB); PG8_STAGE_B(0, 1, cB); PG8_STAGE_A(0, 0, cA, false); PG8_STAGE_A(0, 1, cA, false);
    if (wr == 1) PG8_BAR;
    PG8_WAIT_V(2); PG8_BAR;
    PG8_STAGE_B(1, 0, cB + kstep); PG8_STAGE_A(1, 0, cA + kstep, false); PG8_STAGE_B(1, 1, cB + kstep);
    PG8_WAIT_V(6); PG8_BAR;
    for (;;) {
        const bool has_next = S.next(ui + 1, nxt);
        const char* nA = has_next ? nxt.A : cA; const char* nB = has_next ? nxt.B : cB;
        const bool light = LIGHTSKIP && ((cur.x1 >> 16) != 0);
#pragma unroll 1
        for (int t = 0; t < nt; t += 2) {
            const bool last = (t == nt - 2);
            const char* a1 = cA + (size_t)(t + 1) * kstep;
            const char* a2 = last ? nA : cA + (size_t)(t + 2) * kstep; const char* b2 = last ? nB : cB + (size_t)(t + 2) * kstep;
            const char* a3 = a2 + kstep; const char* b3 = b2 + kstep;
            if constexpr (GATHER) { if (last && has_next) S.offsets(nxt, lda, vn); }
            PG8_LDB(B0, 0, 0); PG8_LDB(B1, 0, 1); PG8_SCHED; PG8_LDA(At, 0, 0); PG8_STAGE_A(1, 1, a1, false);
            PG8_WAIT_V(8); PG8_WAIT_L(0); PG8_BAR; PG8_MMA(0, 0, At, B0); PG8_MMA(0, 1, At, B1); PG8_BAR; PG8_SCHED;
            PG8_LDA(At, 0, 1); PG8_STAGE_B(0, 0, b2); PG8_STAGE_B(0, 1, b2); PG8_STAGE_A(0, 0, a2, last);
            PG8_WAIT_V(8); PG8_WAIT_L(0); PG8_BAR; if (!light) { PG8_MMA(1, 0, At, B0); PG8_MMA(1, 1, At, B1); } PG8_BAR; PG8_SCHED;
            PG8_LDB(B0, 1, 0); PG8_LDB(B1, 1, 1); PG8_SCHED; PG8_LDA(At, 1, 0); PG8_STAGE_A(0, 1, a2, last);
            PG8_WAIT_V(8); PG8_WAIT_L(0); PG8_BAR; PG8_MMA(0, 0, At, B0); PG8_MMA(0, 1, At, B1); PG8_BAR; PG8_SCHED;
            PG8_LDA(At, 1, 1); PG8_STAGE_B(1, 0, b3); PG8_STAGE_B(1, 1, b3); PG8_STAGE_A(1, 0, a3, last);
            PG8_WAIT_V(8); PG8_WAIT_L(0); PG8_BAR; if (!light) { PG8_MMA(1, 0, At, B0); PG8_MMA(1, 1, At, B1); } PG8_BAR; PG8_SCHED;
        }
        if (wr == 0) PG8_BAR;
        E(acc, cur, wr, wc, fr, fq, xl, wid, lane);
        if (!has_next) break;
#pragma unroll
        for (int a = 0; a < 2; ++a)
#pragma unroll
            for (int b = 0; b < 2; ++b)
#pragma unroll
                for (int m = 0; m < 4; ++m)
#pragma unroll
                    for (int n = 0; n < 2; ++n) acc[a][b][m][n] = (f32x4){0.f, 0.f, 0.f, 0.f};
        cur = nxt; cA = nA; cB = nB; ++ui;
        if constexpr (GATHER) {
#pragma unroll
            for (int h = 0; h < 2; ++h) { vc[h][0] = vn[h][0]; vc[h][1] = vn[h][1]; } }
        if (wr == 1) PG8_BAR;
    }
    PG8_WAIT_V(0);
    PG8_BAR;
#undef PG8_SA
#undef PG8_SB
#undef PG8_STAGE2
#undef PG8_STAGE_A
#undef PG8_STAGE_B
#undef PG8_LDA
#undef PG8_LDB
#undef PG8_MMA
#undef PG8_WAIT_V
#undef PG8_WAIT_L
#undef PG8_BAR
#undef PG8_SCHED
}

struct PlainSched {
    const char* A; const char* B; int nM, nN, nwg, G, c; size_t tA, tB;
    __device__ __forceinline__ void init(const void* A_, const void* B_, int M, int N, int lda, int ldb, int G_, int c_) { A = (const char*)A_; B = (const char*)B_; nM = M / BM; nN = N / BM; nwg = nM * nN; G = G_; c = c_;
        tA = (size_t)BM * lda * 2; tB = (size_t)BM * ldb * 2; }
    __device__ __forceinline__ bool next(int i, GUnit& u) const {
        const long L = (long)i * G + c; if (L >= nwg) return false;
        int wgid = (int)L; { const int q = nwg / NXCD, r = nwg % NXCD, xcd = wgid % NXCD, off = wgid / NXCD; wgid = (xcd < r ? xcd * (q + 1) : r * (q + 1) + (xcd - r) * q) + off; }
        const int nig = WGM * nN, gid = wgid / nig, fm = gid * WGM, gsz = (nM - fm) < WGM ? (nM - fm) : WGM;
        u.pm = fm + ((wgid % nig) % gsz); u.pn = (wgid % nig) / gsz; u.A = A + (size_t)u.pm * tA; u.B = B + (size_t)u.pn * tB; u.x0 = u.pm * BM; u.x1 = u.pn * BM; return true;
    }
};
struct MNSched {
    const char* kx; const char* vx; const char* wq2; const char* woT; int c, which;
    __device__ __forceinline__ bool next(int i, GUnit& u) const {
        if (i > 0 || c >= 128 || (c >= 64) != (which != 0)) return false;
        const int L = c & 63, b = L >> 5, h = (L >> 3) & 3, t8 = L & 7;
        if (c < 64) { u.A = kx + ((size_t)(b * 256) * 2048 + h * 512) * 2; u.B = wq2 + ((size_t)(t8 * 256) * 2048 + h * 512) * 2; u.x0 = b * 1024 + h * 256; u.x1 = t8 * 256; u.pm = 0; u.pn = 0; }
        else { u.A = woT + ((size_t)(t8 * 256) * 2048 + h * 512) * 2; u.B = vx + ((size_t)(b * 256) * 2048 + h * 512) * 2; u.x0 = b * 2048 + t8 * 256; u.x1 = h * 256; u.pm = 1; u.pn = 0; }
        return true;
    }
};
struct AttnS2Sched {
    const char* S1; const char* MT; int G, c;
    __device__ __forceinline__ bool next(int i, GUnit& u) const {
        const int L = i * G + c; if (L >= 512) return false;
        const int pm = L >> 2, h = L & 3, b = pm >> 6;
        u.pm = pm; u.pn = h; u.A = S1 + (size_t)pm * 256 * 2048 * 2; u.B = MT + ((size_t)(b * 1024 + h * 256) * 2048) * 2; u.x0 = pm * 256; u.x1 = h * 256; return true;
    }
};
struct AttnO2Sched {
    const char* P; const char* NT; int nwg, G, c;
    __device__ __forceinline__ bool next(int i, GUnit& u) const {
        const long L = (long)i * G + c; if (L >= 1024) return false;
        int wgid = (int)L; { const int q = 1024 / NXCD, xcd = wgid % NXCD, off = wgid / NXCD; wgid = xcd * q + off; }
        const int nig = WGM * 8, gid = wgid / nig, fm = gid * WGM;
        u.pm = fm + ((wgid % nig) % WGM); u.pn = (wgid % nig) / WGM; const int b = u.pm >> 6;
        u.A = P + (size_t)u.pm * 256 * 1024 * 2; u.B = NT + ((size_t)(b * 2048 + u.pn * 256) * 1024) * 2; u.x0 = u.pm * BM; u.x1 = u.pn * BM; return true;
    }
};
struct AttnSSched {
    const char* Q; const char* Kx; int G, c;
    __device__ __forceinline__ bool next(int i, GUnit& u) const {
        const int L = i * G + c; if (L >= 512) return false;
        const int pm = L >> 2, h = L & 3, b = pm >> 6;
        u.pm = pm; u.pn = h; u.A = Q + ((size_t)pm * 256 * 2048 + h * 512) * 2; u.B = Kx + ((size_t)b * 256 * 2048 + h * 512) * 2; u.x0 = pm * 256; u.x1 = h * 256; return true;
    }
};
struct AttnPVSched {
    const char* P; const char* Vt; int G, c;
    __device__ __forceinline__ bool next(int i, GUnit& u) const {
        const int L = i * G + c; if (L >= 1024) return false;
        const int pm = L >> 3, h = (L >> 1) & 3, pn = L & 1, b = pm >> 6;
        u.pm = pm; u.pn = pn; u.A = P + ((size_t)pm * 256 * 1024 + h * 256) * 2; u.B = Vt + ((size_t)(h * 512 + pn * 256) * 512 + b * 256) * 2; u.x0 = pm * 256; u.x1 = h * 512 + pn * 256; return true;
    }
};
struct MoeSched {
    const LAS int* ct; const LAS int* cnt; int npn, G, c; int second;
    const unsigned char* ws; const LAS int* tl;
    __device__ __forceinline__ bool next(int i, GUnit& u) const {
        const int r = c >> 3, W = G >> 3, idx = i * W + r, ti = idx / npn, pn = idx - ti * npn;
        if (ti >= __builtin_amdgcn_readfirstlane(tl[-1])) return false;
        const int ent = __builtin_amdgcn_readfirstlane(tl[ti]), e = ent & 0xff, j = (ent >> 8) & 0xff, light = ent >> 16;
        const int tau = __builtin_amdgcn_readfirstlane(ct[e]) + j;
        u.pm = e; u.pn = pn; u.x0 = tau; u.x1 = j | (light << 16);
        const char* w = (const char*)opaque_uniform(ws);
        if (!second) { u.A = w + WS_S2; u.B = w + WS_W13T + ((size_t)(e * 1024 + pn * 256) * 2048) * 2; }
        else { u.A = w + WS_REGA + ((size_t)tau * 256 * 512) * 2; u.B = w + WS_W2T + ((size_t)(e * 2048 + pn * 256) * 512) * 2; }
        return true;
    }
    __device__ __forceinline__ void offsets(const GUnit& u, int lda, unsigned (&vo)[2][2]) const {
        const int tid = otid(); int R[2], C[2];
#pragma unroll
        for (int i = 0; i < 2; ++i) stage_rc(tid * 16 + i * 8192, R[i], C[i]);
        const int e = u.pm, j = u.x1 & 0xffff, n = cnt[e]; const int* slot = (const int*)(opaque_uniform(ws) + WS_SLOT);
#pragma unroll
        for (int h = 0; h < 2; ++h)
#pragma unroll
            for (int i = 0; i < 2; ++i) { const int idx = j * 256 + h * 128 + R[i]; int tok = 0; if (idx < n) tok = slot[(size_t)e * CAP + idx] >> 1;
                vo[h][i] = (unsigned)(tok * lda + C[i]) * 2u; }
    }
};

struct EpiF32 {
    static constexpr bool PERM = false;
    float* C; int ldc;
    __device__ __forceinline__ void operator()(Acc& acc, const GUnit& u, int wr, int wc, int fr, int fq, LAS unsigned char*, int, int) const {
        const int row0 = u.x0 + wr * 64 + fr, col0 = u.x1 + wc * 32 + 4 * fq;
#pragma unroll
        for (int ai = 0; ai < 2; ++ai)
#pragma unroll
            for (int m = 0; m < 4; ++m) { float* rowp = C + (size_t)(row0 + ai * HALF + m * 16) * ldc + col0;
#pragma unroll
                for (int bj = 0; bj < 2; ++bj)
#pragma unroll
                    for (int n = 0; n < 2; ++n) *(f32x4*)(rowp + bj * HALF + n * 16) = acc[ai][bj][m][n]; }
    }
};
template <bool NT> struct EpiBf16T {
    static constexpr bool PERM = true;
    bf16_t* O; int ldc;
    __device__ __forceinline__ void operator()(Acc& acc, const GUnit& u, int wr, int wc, int fr, int fq, LAS unsigned char*, int, int) const {
        const int row0 = u.x0 + wr * 64 + fr, col0 = u.x1 + wc * 32 + 8 * fq;
#pragma unroll
        for (int ai = 0; ai < 2; ++ai)
#pragma unroll
            for (int m = 0; m < 4; ++m) { bf16_t* rowp = O + (size_t)(row0 + ai * HALF + m * 16) * ldc + col0;
#pragma unroll
                for (int bj = 0; bj < 2; ++bj) { const f32x4 v0 = acc[ai][bj][m][0], v1 = acc[ai][bj][m][1];
                    u32x4 w; w.x = cvt_pk_bf16(v0[0], v0[1]); w.y = cvt_pk_bf16(v0[2], v0[3]); w.z = cvt_pk_bf16(v1[0], v1[1]); w.w = cvt_pk_bf16(v1[2], v1[3]);
                    if constexpr (NT) __builtin_nontemporal_store(w, (u32x4*)(rowp + bj * HALF)); else *(u32x4*)(rowp + bj * HALF) = w; } }
    }
};
typedef EpiBf16T<false> EpiBf16;

struct EpiResid1 {
    static constexpr bool PERM = true;
    bf16_t* S; const bf16_t* h0b; float* part;
    __device__ __forceinline__ void operator()(Acc& acc, const GUnit& u, int wr, int wc, int fr, int fq, LAS unsigned char*, int, int) const {
        const int row0 = u.x0 + wr * 64 + fr, col0 = u.x1 + wc * 32 + 8 * fq;
#pragma unroll
        for (int ai = 0; ai < 2; ++ai)
#pragma unroll
            for (int m = 0; m < 4; ++m) { const int row = row0 + ai * HALF + m * 16; float ps = 0.f, pq = 0.f;
#pragma unroll
                for (int bj = 0; bj < 2; ++bj) { const size_t o = (size_t)row * DM + col0 + bj * HALF; const u32x4 hw = *(const u32x4*)(h0b + o);
                    const f32x4 s0 = (f32x4){bflo(hw.x), bfhi(hw.x), bflo(hw.y), bfhi(hw.y)} * ALPHA + acc[ai][bj][m][0], s1 = (f32x4){bflo(hw.z), bfhi(hw.z), bflo(hw.w), bfhi(hw.w)} * ALPHA + acc[ai][bj][m][1];
                    ps += ((s0[0] + s0[1]) + (s0[2] + s0[3])) + ((s1[0] + s1[1]) + (s1[2] + s1[3]));
                    pq += ((s0[0] * s0[0] + s0[1] * s0[1]) + (s0[2] * s0[2] + s0[3] * s0[3])) + ((s1[0] * s1[0] + s1[1] * s1[1]) + (s1[2] * s1[2] + s1[3] * s1[3]));
                    u32x4 w; w.x = cvt_pk_bf16(s0[0], s0[1]); w.y = cvt_pk_bf16(s0[2], s0[3]); w.z = cvt_pk_bf16(s1[0], s1[1]); w.w = cvt_pk_bf16(s1[2], s1[3]); *(u32x4*)(S + o) = w; }
                ps = xrow_sum(ps); pq = xrow_sum(pq);
                if (fq == 0) *(f32x2*)(part + ((size_t)row * 32 + u.pn * 4 + wc) * 2) = (f32x2){ps, pq}; }
    }
};
__device__ __forceinline__ void panel_stats_from_parts(const float* part, int rowbase, LAS unsigned char* xl, int tid, float* gout = nullptr) {
    LAS f32x2* tab = (LAS f32x2*)xl;
    if (tid < 256) { const float* pr = part + (size_t)(rowbase + tid) * 64; float s = 0.f, q = 0.f;
#pragma unroll
        for (int i = 0; i < 16; ++i) { const f32x4 v = *(const f32x4*)(pr + 4 * i); s += v[0] + v[2]; q += v[1] + v[3]; }
        const float mean = s * (1.0f / DM), var = fmaxf(q * (1.0f / DM) - mean * mean, 0.f);
        const f32x2 mr = (f32x2){mean, rsqrtf(var + 1e-5f)}; tab[tid] = mr; if (gout) *(f32x2*)(gout + (size_t)(rowbase + tid) * 2) = mr; }
    asm volatile("s_waitcnt lgkmcnt(0)" ::: "memory"); __builtin_amdgcn_s_barrier(); asm volatile("" ::: "memory");
}
struct EpiResid2 {
    static constexpr bool PERM = true;
    bf16_t* S2; const bf16_t* S1; const float* stats1; float* part2; const float* g1; const float* b1;
    __device__ __forceinline__ void operator()(Acc& acc, const GUnit& u, int wr, int wc, int fr, int fq, LAS unsigned char*, int, int) const {
        const int row0 = u.x0 + wr * 64 + fr, col0 = u.x1 + wc * 32 + 8 * fq;
        f32x4 Gv[2][2], Bv[2][2];
#pragma unroll
        for (int bj = 0; bj < 2; ++bj)
#pragma unroll
            for (int n = 0; n < 2; ++n) { Gv[bj][n] = *(const f32x4*)(g1 + col0 + bj * HALF + 4 * n) * ALPHA; Bv[bj][n] = *(const f32x4*)(b1 + col0 + bj * HALF + 4 * n) * ALPHA; }
#pragma unroll
        for (int ai = 0; ai < 2; ++ai)
#pragma unroll
            for (int m = 0; m < 4; ++m) { const int row = row0 + ai * HALF + m * 16; const f32x2 st = *(const f32x2*)(stats1 + (size_t)row * 2); float ps = 0.f, pq = 0.f;
#pragma unroll
                for (int bj = 0; bj < 2; ++bj) { const size_t o = (size_t)row * DM + col0 + bj * HALF; const u32x4 hw = *(const u32x4*)(S1 + o);
                    const f32x4 s0 = (((f32x4){bflo(hw.x), bfhi(hw.x), bflo(hw.y), bfhi(hw.y)} - st.x) * st.y) * Gv[bj][0] + Bv[bj][0] + acc[ai][bj][m][0];
                    const f32x4 s1 = (((f32x4){bflo(hw.z), bfhi(hw.z), bflo(hw.w), bfhi(hw.w)} - st.x) * st.y) * Gv[bj][1] + Bv[bj][1] + acc[ai][bj][m][1];
                    ps += ((s0[0] + s0[1]) + (s0[2] + s0[3])) + ((s1[0] + s1[1]) + (s1[2] + s1[3]));
                    pq += ((s0[0] * s0[0] + s0[1] * s0[1]) + (s0[2] * s0[2] + s0[3] * s0[3])) + ((s1[0] * s1[0] + s1[1] * s1[1]) + (s1[2] * s1[2] + s1[3] * s1[3]));
                    u32x4 w; w.x = cvt_pk_bf16(s0[0], s0[1]); w.y = cvt_pk_bf16(s0[2], s0[3]); w.z = cvt_pk_bf16(s1[0], s1[1]); w.w = cvt_pk_bf16(s1[2], s1[3]); *(u32x4*)(S2 + o) = w; }
                ps = xrow_sum(ps); pq = xrow_sum(pq);
                if (fq == 0) *(f32x2*)(part2 + ((size_t)row * 32 + u.pn * 4 + wc) * 2) = (f32x2){ps, pq}; }
    }
};
struct EpiAffineBf16 {
    static constexpr bool PERM = true;
    bf16_t* O; int ldc; const float* part; const float* G; const float* B;
    __device__ __forceinline__ void operator()(Acc& acc, const GUnit& u, int wr, int wc, int fr, int fq, LAS unsigned char* xl, int wid, int lane) const {
        panel_stats_from_parts(part, u.x0, xl, wid * 64 + lane);
        const LAS f32x2* tab = (const LAS f32x2*)xl;
        const int row0 = u.x0 + wr * 64 + fr, col0 = u.x1 + wc * 32 + 8 * fq;
        f32x4 Gv[2][2], Bv[2][2];
#pragma unroll
        for (int bj = 0; bj < 2; ++bj)
#pragma unroll
            for (int n = 0; n < 2; ++n) { Gv[bj][n] = *(const f32x4*)(G + col0 + bj * HALF + 4 * n); Bv[bj][n] = *(const f32x4*)(B + col0 + bj * HALF + 4 * n); }
#pragma unroll
        for (int ai = 0; ai < 2; ++ai)
#pragma unroll
            for (int m = 0; m < 4; ++m) { const int rl = ai * HALF + wr * 64 + m * 16 + fr; const f32x2 st = tab[rl];
                bf16_t* rowp = O + (size_t)(row0 + ai * HALF + m * 16) * ldc + col0;
#pragma unroll
                for (int bj = 0; bj < 2; ++bj) { const f32x4 v0 = (acc[ai][bj][m][0] - Gv[bj][0] * st.x) * st.y + Bv[bj][0], v1 = (acc[ai][bj][m][1] - Gv[bj][1] * st.x) * st.y + Bv[bj][1];
                    u32x4 w; w.x = cvt_pk_bf16(v0[0], v0[1]); w.y = cvt_pk_bf16(v0[2], v0[3]); w.z = cvt_pk_bf16(v1[0], v1[1]); w.w = cvt_pk_bf16(v1[2], v1[3]);
                    *(u32x4*)(rowp + bj * HALF) = w; } }
        asm volatile("s_waitcnt lgkmcnt(0)" ::: "memory"); __builtin_amdgcn_s_barrier(); asm volatile("" ::: "memory");
    }
};
struct EpiSoftmax {
    static constexpr bool PERM = true;
    bf16_t* P; float c2;
    __device__ __forceinline__ void operator()(Acc& acc, const GUnit& u, int wr, int wc, int fr, int fq, LAS unsigned char* xl, int, int) const {
        LAS f32x2* tab = (LAS f32x2*)xl;
        float mloc[2][4];
#pragma unroll
        for (int ai = 0; ai < 2; ++ai)
#pragma unroll
            for (int m = 0; m < 4; ++m) {
                float mx = -3.0e38f;
#pragma unroll
                for (int bj = 0; bj < 2; ++bj)
#pragma unroll
                    for (int n = 0; n < 2; ++n) { const f32x4 v = acc[ai][bj][m][n]; mx = fmaxf(mx, fmaxf(fmaxf(v[0], v[1]), fmaxf(v[2], v[3]))); }
                mx = xrow_max(mx);
                float s = 0.f;
#pragma unroll
                for (int bj = 0; bj < 2; ++bj)
#pragma unroll
                    for (int n = 0; n < 2; ++n) { f32x4 v = acc[ai][bj][m][n];
#pragma unroll
                        for (int j = 0; j < 4; ++j) { v[j] = __builtin_amdgcn_exp2f((v[j] - mx) * c2); s += v[j]; }
                        acc[ai][bj][m][n] = v; }
                s = xrow_sum(s);
                mloc[ai][m] = mx;
                if (fq == 0) tab[(ai * HALF + wr * 64 + m * 16 + fr) * 4 + wc] = (f32x2){mx, s};
            }
        asm volatile("s_waitcnt lgkmcnt(0)" ::: "memory"); __builtin_amdgcn_s_barrier(); asm volatile("" ::: "memory");
        const int row0 = u.x0 + wr * 64 + fr, col0 = u.x1 + wc * 32 + 8 * fq;
#pragma unroll
        for (int ai = 0; ai < 2; ++ai)
#pragma unroll
            for (int m = 0; m < 4; ++m) {
                const int r = ai * HALF + wr * 64 + m * 16 + fr;
                const f32x2 t0 = tab[r * 4 + 0], t1 = tab[r * 4 + 1], t2 = tab[r * 4 + 2], t3 = tab[r * 4 + 3];
                const float M = fmaxf(fmaxf(t0.x, t1.x), fmaxf(t2.x, t3.x));
                const float tot = t0.y * __builtin_amdgcn_exp2f((t0.x - M) * c2) + t1.y * __builtin_amdgcn_exp2f((t1.x - M) * c2) + t2.y * __builtin_amdgcn_exp2f((t2.x - M) * c2) + t3.y * __builtin_amdgcn_exp2f((t3.x - M) * c2);
                const float f = __builtin_amdgcn_exp2f((mloc[ai][m] - M) * c2) / tot;
                bf16_t* rowp = P + (size_t)(row0 + ai * HALF + m * 16) * 1024 + col0;
#pragma unroll
                for (int bj = 0; bj < 2; ++bj) { const f32x4 v0 = acc[ai][bj][m][0] * f, v1 = acc[ai][bj][m][1] * f;
                    u32x4 w; w.x = cvt_pk_bf16(v0[0], v0[1]); w.y = cvt_pk_bf16(v0[2], v0[3]); w.z = cvt_pk_bf16(v1[0], v1[1]); w.w = cvt_pk_bf16(v1[2], v1[3]);
                    *(u32x4*)(rowp + bj * HALF) = w; }
            }
        asm volatile("s_waitcnt lgkmcnt(0)" ::: "memory"); __builtin_amdgcn_s_barrier(); asm volatile("" ::: "memory");
    }
};
struct EpiSoftmax2 {
    static constexpr bool PERM = true;
    bf16_t* P; float c2; const float* part; const float* GK; const float* BK; float* stats1;
    __device__ __forceinline__ void operator()(Acc& acc, const GUnit& u, int wr, int wc, int fr, int fq, LAS unsigned char* xl, int wid, int lane) const {
        panel_stats_from_parts(part, u.x0, xl, wid * 64 + lane, u.pn == 0 ? stats1 : nullptr);
        const LAS f32x2* st = (const LAS f32x2*)xl; LAS f32x2* tab = (LAS f32x2*)(xl + 2048);
        const int b = u.pm >> 6, gcol = b * 1024 + u.x1 + wc * 32 + 8 * fq;
        f32x4 Gv[2][2], Bv[2][2];
#pragma unroll
        for (int bj = 0; bj < 2; ++bj)
#pragma unroll
            for (int n = 0; n < 2; ++n) { Gv[bj][n] = *(const f32x4*)(GK + gcol + bj * HALF + 4 * n); Bv[bj][n] = *(const f32x4*)(BK + gcol + bj * HALF + 4 * n); }
        float mloc[2][4];
#pragma unroll
        for (int ai = 0; ai < 2; ++ai)
#pragma unroll
            for (int m = 0; m < 4; ++m) { const f32x2 sr = st[ai * HALF + wr * 64 + m * 16 + fr];
                float mx = -3.0e38f;
#pragma unroll
                for (int bj = 0; bj < 2; ++bj)
#pragma unroll
                    for (int n = 0; n < 2; ++n) { const f32x4 v = (acc[ai][bj][m][n] - Gv[bj][n] * sr.x) * sr.y + Bv[bj][n]; acc[ai][bj][m][n] = v; mx = fmaxf(mx, fmaxf(fmaxf(v[0], v[1]), fmaxf(v[2], v[3]))); }
                mx = xrow_max(mx);
                float s = 0.f;
#pragma unroll
                for (int bj = 0; bj < 2; ++bj)
#pragma unroll
                    for (int n = 0; n < 2; ++n) { f32x4 v = acc[ai][bj][m][n];
#pragma unroll
                        for (int j = 0; j < 4; ++j) { v[j] = __builtin_amdgcn_exp2f((v[j] - mx) * c2); s += v[j]; }
                        acc[ai][bj][m][n] = v; }
                s = xrow_sum(s);
                mloc[ai][m] = mx;
                if (fq == 0) tab[(ai * HALF + wr * 64 + m * 16 + fr) * 4 + wc] = (f32x2){mx, s};
            }
        asm volatile("s_waitcnt lgkmcnt(0)" ::: "memory"); __builtin_amdgcn_s_barrier(); asm volatile("" ::: "memory");
        const int row0 = u.x0 + wr * 64 + fr, col0 = u.x1 + wc * 32 + 8 * fq;
#pragma unroll
        for (int ai = 0; ai < 2; ++ai)
#pragma unroll
            for (int m = 0; m < 4; ++m) {
                const int r = ai * HALF + wr * 64 + m * 16 + fr;
                const f32x2 t0 = tab[r * 4 + 0], t1 = tab[r * 4 + 1], t2 = tab[r * 4 + 2], t3 = tab[r * 4 + 3];
                const float M = fmaxf(fmaxf(t0.x, t1.x), fmaxf(t2.x, t3.x));
                const float tot = t0.y * __builtin_amdgcn_exp2f((t0.x - M) * c2) + t1.y * __builtin_amdgcn_exp2f((t1.x - M) * c2) + t2.y * __builtin_amdgcn_exp2f((t2.x - M) * c2) + t3.y * __builtin_amdgcn_exp2f((t3.x - M) * c2);
                const float f = __builtin_amdgcn_exp2f((mloc[ai][m] - M) * c2) / tot;
                bf16_t* rowp = P + (size_t)(row0 + ai * HALF + m * 16) * 1024 + col0;
#pragma unroll
                for (int bj = 0; bj < 2; ++bj) { const f32x4 v0 = acc[ai][bj][m][0] * f, v1 = acc[ai][bj][m][1] * f;
                    u32x4 w; w.x = cvt_pk_bf16(v0[0], v0[1]); w.y = cvt_pk_bf16(v0[2], v0[3]); w.z = cvt_pk_bf16(v1[0], v1[1]); w.w = cvt_pk_bf16(v1[2], v1[3]);
                    *(u32x4*)(rowp + bj * HALF) = w; }
            }
        asm volatile("s_waitcnt lgkmcnt(0)" ::: "memory"); __builtin_amdgcn_s_barrier(); asm volatile("" ::: "memory");
    }
};
struct EpiSwiGLU {
    static constexpr bool PERM = true;
    bf16_t* H; const unsigned char* ws; const LAS int* cnt;
    __device__ __forceinline__ void operator()(Acc& acc, const GUnit& u, int wr, int wc, int fr, int fq, LAS unsigned char* xl, int wid, int lane) const {
        const unsigned char* wsb = opaque_uniform(ws);
        const int* slot = (const int*)(wsb + WS_SLOT); const float* stats2 = (const float*)(wsb + WS_STATS2); const float* G13 = (const float*)(wsb + WS_G13); const float* B13 = (const float*)(wsb + WS_B13);
        LAS f32x2* tab = (LAS f32x2*)xl; LAS float* Gl = (LAS float*)(xl + 2048); LAS float* Bl = Gl + 256;
        { const int t = otid(), e = u.pm;
          if (t < 256) { const int idx = (u.x1 & 0xffff) * 256 + t; int tok = 0; if (idx < cnt[e]) tok = slot[(size_t)e * CAP + idx] >> 1; tab[t] = *(const f32x2*)(stats2 + (size_t)tok * 2); }
          else { const int cI = e * 1024 + u.pn * 256 + (t - 256); Gl[t - 256] = G13[cI]; Bl[t - 256] = B13[cI]; } }
        asm volatile("s_waitcnt vmcnt(0) lgkmcnt(0)" ::: "memory"); __builtin_amdgcn_s_barrier(); asm volatile("" ::: "memory");
        const int row0 = u.x0 * 256 + wr * 64 + fr, col0 = u.pn * 128 + wc * 32 + 8 * fq, cl = wc * 32 + 8 * fq;
#pragma unroll
        for (int ai = 0; ai < 2; ++ai)
#pragma unroll
            for (int m = 0; m < 4; ++m) { const int rl = ai * HALF + wr * 64 + m * 16 + fr; const f32x2 st = tab[rl];
                bf16_t* rowp = H + (size_t)(row0 + ai * HALF + m * 16) * 512 + col0;
                float h[8];
#pragma unroll
                for (int nn = 0; nn < 2; ++nn) { const f32x4 g0 = *(const LAS f32x4*)(Gl + cl + 4 * nn), g1 = *(const LAS f32x4*)(Gl + HALF + cl + 4 * nn), b0 = *(const LAS f32x4*)(Bl + cl + 4 * nn), b1 = *(const LAS f32x4*)(Bl + HALF + cl + 4 * nn);
                    const f32x4 a4 = (acc[ai][0][m][nn] - g0 * st.x) * st.y + b0, b4 = (acc[ai][1][m][nn] - g1 * st.x) * st.y + b1;
#pragma unroll
                    for (int jj = 0; jj < 4; ++jj) { const float a = a4[jj], b = b4[jj]; h[nn * 4 + jj] = a * b / (1.0f + __builtin_amdgcn_exp2f(-a * 1.4426950408889634f)); } }
                u32x4 w; w.x = cvt_pk_bf16(h[0], h[1]); w.y = cvt_pk_bf16(h[2], h[3]); w.z = cvt_pk_bf16(h[4], h[5]); w.w = cvt_pk_bf16(h[6], h[7]);
                *(u32x4*)rowp = w; __builtin_amdgcn_sched_barrier(0); }
        asm volatile("s_waitcnt lgkmcnt(0)" ::: "memory"); __builtin_amdgcn_s_barrier(); asm volatile("" ::: "memory");
    }
};
struct EpiScatter {
    static constexpr bool PERM = true;
    bf16_t* Y; const int* slot; const LAS int* cnt;
    __device__ __forceinline__ void operator()(Acc& acc, const GUnit& u, int wr, int wc, int fr, int fq, LAS unsigned char*, int, int) const {
        const int e = u.pm, j = u.x1 & 0xffff, n = cnt[e];
        const int col0 = u.pn * 256 + wc * 32 + 8 * fq;
#pragma unroll
        for (int ai = 0; ai < 2; ++ai)
#pragma unroll
            for (int m = 0; m < 4; ++m) { const int idx = j * 256 + ai * HALF + wr * 64 + m * 16 + fr;
                if (idx < n) { const int dest = slot[(size_t)e * CAP + idx]; bf16_t* rowp = Y + (size_t)dest * 2048 + col0;
#pragma unroll
                    for (int bj = 0; bj < 2; ++bj) { const f32x4 v0 = acc[ai][bj][m][0], v1 = acc[ai][bj][m][1];
                        u32x4 w; w.x = cvt_pk_bf16(v0[0], v0[1]); w.y = cvt_pk_bf16(v0[2], v0[3]); w.z = cvt_pk_bf16(v1[0], v1[1]); w.w = cvt_pk_bf16(v1[2], v1[3]);
                        *(u32x4*)(rowp + bj * HALF) = w; } } }
    }
};
}

__device__ __forceinline__ void ph_ln0(const Params& p, LAS unsigned char* lds) {
    const int tid = otid(), wid = __builtin_amdgcn_readfirstlane(tid >> 6), lane = tid & 63, m16 = lane & 15, q4 = lane >> 4;
    LAS unsigned char* xb = lds;
    LAS float* red = (LAS float*)(lds + 131072);
    LAS f32x4* pacc = (LAS f32x4*)(lds + 131072 + 1024);
    LAS float* csum = (LAS float*)(lds + 131072 + 1024 + 8192);
    bf16x8 Whi[8], Wlo[8];
    {
        float ps0 = 0.f, pb0 = 0.f;
#pragma unroll
        for (int s = 0; s < 8; ++s) { const int k0 = 256 * wid + 32 * s + 8 * q4; float w[8];
#pragma unroll
            for (int j = 0; j < 8; ++j) { const float wr = p.w_in[(size_t)(k0 + j) * NIN + NPROJ + m16]; w[j] = wr * p.ln0_g[k0 + j]; pb0 += wr * p.ln0_b[k0 + j]; ps0 += w[j]; }
            u32x4 hi, lo; hi.x = cvt_pk_bf16(w[0], w[1]); hi.y = cvt_pk_bf16(w[2], w[3]); hi.z = cvt_pk_bf16(w[4], w[5]); hi.w = cvt_pk_bf16(w[6], w[7]);
            lo.x = cvt_pk_bf16(w[0] - bflo(hi.x), w[1] - bfhi(hi.x)); lo.y = cvt_pk_bf16(w[2] - bflo(hi.y), w[3] - bfhi(hi.y));
            lo.z = cvt_pk_bf16(w[4] - bflo(hi.z), w[5] - bfhi(hi.z)); lo.w = cvt_pk_bf16(w[6] - bflo(hi.w), w[7] - bfhi(hi.w));
            Whi[s] = __builtin_bit_cast(bf16x8, hi); Wlo[s] = __builtin_bit_cast(bf16x8, lo); }
        const float a = xrow_sum(ps0), b = xrow_sum(pb0);
        if (lane < 16) { csum[wid * 32 + lane] = a; csum[wid * 32 + 16 + lane] = b; }
        __syncthreads();
        if (tid < 32) { float t = 0.f;
#pragma unroll
            for (int w8 = 0; w8 < 8; ++w8) t += csum[w8 * 32 + tid];
            csum[256 + tid] = t; }
        __syncthreads();
    }
    bf16_t* h0b = (bf16_t*)(p.ws + WS_REGA); float* ab = (float*)(p.ws + WS_AB);
#define LN_DMA(rb) do { _Pragma("unroll") for (int _i = 0; _i < 16; ++_i) { const int _seg = wid * 16 + _i, _r = _seg >> 3, _sg = _seg & 7; \
        __builtin_amdgcn_global_load_lds((const unsigned*)(p.x + (size_t)((rb) + _r) * DM + (_sg * 64 + (lane ^ _r)) * 4), (LAS unsigned*)(xb + _seg * 1024), 16, 0, 0); } } while (0)
    for (int blk = blockIdx.x; blk < T_TOK / 128; blk += gridDim.x) {
        const int rowbase = blk * 128;
        LN_DMA(rowbase);
        for (int bt = 0; bt < 8; ++bt) { const int rb = rowbase + bt * 16;
            asm volatile("s_waitcnt vmcnt(0)" ::: "memory"); __builtin_amdgcn_s_barrier(); asm volatile("" ::: "memory");
            f32x4 xv[8][2];
#pragma unroll
            for (int s = 0; s < 8; ++s)
#pragma unroll
                for (int h = 0; h < 2; ++h) xv[s][h] = *(const LAS f32x4*)(xb + m16 * 8192 + (((64 * wid + 8 * s + 2 * q4 + h) ^ m16) << 4));
            asm volatile("s_waitcnt lgkmcnt(0)" ::: "memory"); __builtin_amdgcn_s_barrier(); asm volatile("" ::: "memory");
            if (bt + 1 < 8) LN_DMA(rb + 16);
            float ps = 0.f, pq = 0.f;
#pragma unroll
            for (int s = 0; s < 8; ++s)
#pragma unroll
                for (int h = 0; h < 2; ++h) { const f32x4 v = xv[s][h]; ps += (v[0] + v[1]) + (v[2] + v[3]); pq += (v[0] * v[0] + v[1] * v[1]) + (v[2] * v[2] + v[3] * v[3]); }
            ps = xrow_sum(ps); pq = xrow_sum(pq);
            if (lane < 16) *(LAS f32x2*)(red + (wid * 16 + lane) * 2) = (f32x2){ps, pq};
            f32x4 acc = (f32x4){0.f, 0.f, 0.f, 0.f};
#pragma unroll
            for (int s = 0; s < 8; ++s) { const f32x4 a0 = xv[s][0], a1 = xv[s][1];
                u32x4 hw, lw;
                hw.x = cvt_pk_bf16(a0[0], a0[1]); hw.y = cvt_pk_bf16(a0[2], a0[3]); hw.z = cvt_pk_bf16(a1[0], a1[1]); hw.w = cvt_pk_bf16(a1[2], a1[3]);
                lw.x = cvt_pk_bf16(a0[0] - bflo(hw.x), a0[1] - bfhi(hw.x)); lw.y = cvt_pk_bf16(a0[2] - bflo(hw.y), a0[3] - bfhi(hw.y));
                lw.z = cvt_pk_bf16(a1[0] - bflo(hw.z), a1[1] - bfhi(hw.z)); lw.w = cvt_pk_bf16(a1[2] - bflo(hw.w), a1[3] - bfhi(hw.w));
                const bf16x8 Ahi = __builtin_bit_cast(bf16x8, hw), Alo = __builtin_bit_cast(bf16x8, lw);
                acc = __builtin_amdgcn_mfma_f32_16x16x32_bf16(Whi[s], Ahi, acc, 0, 0, 0);
                acc = __builtin_amdgcn_mfma_f32_16x16x32_bf16(Wlo[s], Ahi, acc, 0, 0, 0);
                acc = __builtin_amdgcn_mfma_f32_16x16x32_bf16(Whi[s], Alo, acc, 0, 0, 0); }
            pacc[wid * 64 + lane] = acc;
            asm volatile("s_waitcnt lgkmcnt(0)" ::: "memory"); __builtin_amdgcn_s_barrier(); asm volatile("" ::: "memory");
            float S = 0.f, Q = 0.f;
#pragma unroll
            for (int w8 = 0; w8 < 8; ++w8) { const f32x2 t = *(const LAS f32x2*)(red + (w8 * 16 + m16) * 2); S += t.x; Q += t.y; }
            const float mean = S * (1.0f / DM), rstd = rsqrtf(fmaxf(Q * (1.0f / DM) - mean * mean, 0.f) + 1e-5f);
            bf16_t* orow = h0b + (size_t)(rb + m16) * DM + 256 * wid + 8 * q4;
#pragma unroll
            for (int s = 0; s < 8; ++s) { const int k = 256 * wid + 32 * s + 8 * q4;
                const f32x4 g0 = *(const f32x4*)(p.ln0_g + k), g1 = *(const f32x4*)(p.ln0_g + k + 4), b0 = *(const f32x4*)(p.ln0_b + k), b1 = *(const f32x4*)(p.ln0_b + k + 4);
                const f32x4 h0 = (xv[s][0] - mean) * rstd * g0 + b0, h1 = (xv[s][1] - mean) * rstd * g1 + b1;
                u32x4 w; w.x = cvt_pk_bf16(h0[0], h0[1]); w.y = cvt_pk_bf16(h0[2], h0[3]); w.z = cvt_pk_bf16(h1[0], h1[1]); w.w = cvt_pk_bf16(h1[2], h1[3]);
                *(u32x4*)(orow + 32 * s) = w; }
            if (wid == (bt & 7)) {
                f32x4 t = (f32x4){0.f, 0.f, 0.f, 0.f};
#pragma unroll
                for (int w8 = 0; w8 < 8; ++w8) t += pacc[w8 * 64 + lane];
                f32x4 o;
#pragma unroll
                for (int r = 0; r < 4; ++r) o[r] = rstd * (t[r] - mean * csum[256 + 4 * q4 + r]) + csum[256 + 16 + 4 * q4 + r];
                *(f32x4*)(ab + (size_t)(rb + m16) * 16 + 4 * q4) = o; }
        }
        __syncthreads();
    }
#undef LN_DMA
    bf16_t* memb = (bf16_t*)(p.ws + WS_MEMB);
    for (int i = blockIdx.x * NTHR + tid; i < 512 * 2048 / 4; i += gridDim.x * NTHR) { const f32x4 m = *(const f32x4*)(p.mem + (size_t)i * 4);
        u32x2 w; w.x = cvt_pk_bf16(m[0], m[1]); w.y = cvt_pk_bf16(m[2], m[3]); *(u32x2*)(memb + (size_t)i * 4) = w; }
}

struct TrJob { const float* src; int lds_, col0, k0; bf16_t* dst; int ldd; const float* gk; const float* bk; float* Gn; float* Bn; };
template <bool FOLD>
__device__ __forceinline__ void transpose_batch(const TrJob (&J)[4], int nj, LAS float* tiles, f32x4& ag, f32x4& ab) {
    const int tid = otid(); const int kr = tid >> 4, c4 = tid & 15;
    f32x4 v[4][2]; float gs[4][2], bs[4][2];
#pragma unroll
    for (int t = 0; t < 4; ++t) if (t < nj) {
#pragma unroll
        for (int pss = 0; pss < 2; ++pss) { v[t][pss] = *(const f32x4*)(J[t].src + (size_t)(J[t].k0 + kr + pss * 32) * J[t].lds_ + J[t].col0 + c4 * 4);
            if constexpr (FOLD) { gs[t][pss] = J[t].gk[J[t].k0 + kr + pss * 32]; bs[t][pss] = J[t].bk[J[t].k0 + kr + pss * 32]; } } }
#pragma unroll
    for (int t = 0; t < 4; ++t) if (t < nj) { LAS float* tile = tiles + t * 4160;
#pragma unroll
        for (int pss = 0; pss < 2; ++pss) { const int k = kr + pss * 32;
            if constexpr (FOLD) { ab += v[t][pss] * bs[t][pss]; v[t][pss] *= gs[t][pss]; ag += v[t][pss]; }
            tile[k * 65 + c4 * 4 + 0] = v[t][pss][0]; tile[k * 65 + c4 * 4 + 1] = v[t][pss][1]; tile[k * 65 + c4 * 4 + 2] = v[t][pss][2]; tile[k * 65 + c4 * 4 + 3] = v[t][pss][3]; } }
    __syncthreads();
    { const int n = tid >> 3, kc = tid & 7;
#pragma unroll
        for (int t = 0; t < 4; ++t) if (t < nj) { const LAS float* tile = tiles + t * 4160; float f[8];
#pragma unroll
            for (int j = 0; j < 8; ++j) f[j] = tile[(kc * 8 + j) * 65 + n];
            u32x4 w; w.x = cvt_pk_bf16(f[0], f[1]); w.y = cvt_pk_bf16(f[2], f[3]); w.z = cvt_pk_bf16(f[4], f[5]); w.w = cvt_pk_bf16(f[6], f[7]);
            *(u32x4*)(J[t].dst + (size_t)n * J[t].ldd + J[t].k0 + kc * 8) = w; } }
    __syncthreads();
}
constexpr int TR_WIN = 96 * 32, TR_SQ = 32 * 32, TR_W13 = NEXP * 16 * 32, TR_W2 = NEXP * 32 * 8;
constexpr int TR_SMALL = TR_WIN + 4 * TR_SQ, TR_ALL = TR_SMALL + TR_W13 + TR_W2;
__device__ __forceinline__ TrJob tr_job(const Params& p, int id) {
    if (id < TR_WIN) { const int nt = id / 32, kt = id % 32; return TrJob{p.w_in, NIN, nt * 64, kt * 64, (bf16_t*)(p.ws + WS_WINT) + (size_t)nt * 64 * DM, DM, nullptr, nullptr, nullptr, nullptr}; }
    id -= TR_WIN;
    if (id < 4 * TR_SQ) { const int w4 = id / TR_SQ, w = w4 == 0 ? 0 : w4 + 1, r = id % TR_SQ, nt = r / 32, kt = r % 32;
        const float* src = w == 0 ? p.w_out : w == 2 ? p.wk : w == 3 ? p.wv : p.wo;
        TrJob j{src, DM, nt * 64, kt * 64, (bf16_t*)(p.ws + WS_WOUTT + (size_t)w * 8 * MiB) + (size_t)nt * 64 * DM, DM, nullptr, nullptr, nullptr, nullptr};
        return j; }
    id -= 4 * TR_SQ;
    if (id < TR_W13) { const int e = id / 512, r = id % 512, ntile = r / 32, kt = r % 32, n0 = ntile * 64, pn = n0 / 256, rr = n0 % 256;
        const float* src = (rr < 128 ? p.w1 : p.w3) + (size_t)e * DM * 512;
        return TrJob{src, 512, pn * 128 + (rr & 127), kt * 64, (bf16_t*)(p.ws + WS_W13T) + ((size_t)e * 1024 + n0) * DM, DM, p.ln2_g, p.ln2_b, (float*)(p.ws + WS_G13) + (size_t)e * 1024 + n0, (float*)(p.ws + WS_B13) + (size_t)e * 1024 + n0}; }
    id -= TR_W13;
    { const int e = id / 256, r = id % 256, ntile = r / 8, kt = r % 8;
        return TrJob{p.w2 + (size_t)e * 512 * DM, DM, ntile * 64, kt * 64, (bf16_t*)(p.ws + WS_W2T) + ((size_t)e * 2048 + ntile * 64) * 512, 512, nullptr, nullptr, nullptr, nullptr}; }
}
__device__ __forceinline__ void ph_transpose(const Params& p, LAS unsigned char* lds, int lo, int hi, int rank, int nwg) {
    for (int id = lo + rank * 4; id < hi; id += nwg * 4) { TrJob J[4]; const int nj = (hi - id) < 4 ? (hi - id) : 4;
#pragma unroll
        for (int t = 0; t < 4; ++t) J[t] = tr_job(p, id + (t < nj ? t : 0));
        f32x4 ag, ab; transpose_batch<false>(J, nj, (LAS float*)lds, ag, ab); }
}
__device__ __forceinline__ void ph_transpose_experts(const Params& p, LAS unsigned char* lds, LAS unsigned char* xl) {
    unsigned* ctr = (unsigned*)(p.ws + WS_CTL + CTL_TRQ); LAS int* sh = (LAS int*)xl;
    __syncthreads();
    if (otid() == 0) sh[0] = (int)atomicAdd(ctr, 1u);
    __syncthreads();
    int s = __builtin_amdgcn_readfirstlane(sh[0]);
    while (s < 1024 + 2048) {
        int nxt = 0; if (otid() == 0) nxt = (int)atomicAdd(ctr, 1u);
        const int lo = s < 1024 ? TR_SMALL + s * 32 : TR_SMALL + TR_W13 + (s - 1024) * 8, n = s < 1024 ? 32 : 8;
        if (s < 1024) { f32x4 ag = (f32x4){0.f, 0.f, 0.f, 0.f}, ab = ag;
            for (int id = lo; id < lo + n; id += 4) { TrJob J[4];
#pragma unroll
                for (int t = 0; t < 4; ++t) J[t] = tr_job(p, id + t);
                transpose_batch<true>(J, 4, (LAS float*)lds, ag, ab); }
            LAS float* red = (LAS float*)lds; const int tid = otid(), kr = tid >> 4, c4 = tid & 15;
            *(LAS f32x4*)(red + kr * 128 + c4 * 4) = ag; *(LAS f32x4*)(red + kr * 128 + 64 + c4 * 4) = ab;
            __syncthreads();
            if (tid < 128) { float sum = 0.f;
#pragma unroll
                for (int i = 0; i < 32; ++i) sum += red[i * 128 + tid];
                ((float*)(p.ws + (tid < 64 ? WS_G13 : WS_B13)))[s * 64 + (tid & 63)] = sum; } }
        else { f32x4 ag, ab;
            for (int id = lo; id < lo + n; id += 4) { TrJob J[4];
#pragma unroll
                for (int t = 0; t < 4; ++t) J[t] = tr_job(p, id + t);
                transpose_batch<false>(J, 4, (LAS float*)lds, ag, ab); } }
        if (otid() == 0) sh[0] = nxt;
        __syncthreads();
        s = __builtin_amdgcn_readfirstlane(sh[0]);
        __syncthreads();
    }
}

__device__ __forceinline__ void ln_row(f32x4 (&v)[8], const float* g, const float* b, int lane) {
    float s = 0.f;
#pragma unroll
    for (int j = 0; j < 8; ++j) s += (v[j][0] + v[j][1]) + (v[j][2] + v[j][3]);
    const float mean = wave_sum(s) * (1.0f / DM); float q = 0.f;
#pragma unroll
    for (int j = 0; j < 8; ++j) { const f32x4 d = v[j] - mean; q += (d[0] * d[0] + d[1] * d[1]) + (d[2] * d[2] + d[3] * d[3]); }
    const float rstd = rsqrtf(wave_sum(q) * (1.0f / DM) + 1e-5f);
#pragma unroll
    for (int j = 0; j < 8; ++j) { const f32x4 gg = *(const f32x4*)(g + j * 256 + lane * 4), bb = *(const f32x4*)(b + j * 256 + lane * 4); v[j] = (v[j] - mean) * rstd * gg + bb; }
}
__device__ __forceinline__ void ph_ln1(const Params& p) {
    const int tid = otid(), wid = tid >> 6, lane = tid & 63;
    const float* stats = (const float*)(p.ws + WS_STATS0); const bf16_t* mix = (const bf16_t*)p.out;
    bf16_t* h1b = (bf16_t*)(p.ws + WS_REGB);
    const int rstep = gridDim.x * 8; int row = blockIdx.x * 8 + wid;
    f32x4 nx[8]; u32x2 nm[8];
    if (row < T_TOK) {
#pragma unroll
        for (int j = 0; j < 8; ++j) { const size_t o = (size_t)row * DM + j * 256 + lane * 4; nx[j] = *(const f32x4*)(p.x + o); nm[j] = *(const u32x2*)(mix + o); } }
    for (; row < T_TOK; row += rstep) {
        const float mean = stats[row * 2], rstd = stats[row * 2 + 1]; f32x4 v[8]; u32x2 mw[8];
#pragma unroll
        for (int j = 0; j < 8; ++j) { v[j] = nx[j]; mw[j] = nm[j]; }
        if (row + rstep < T_TOK) {
#pragma unroll
            for (int j = 0; j < 8; ++j) { const size_t o = (size_t)(row + rstep) * DM + j * 256 + lane * 4; nx[j] = *(const f32x4*)(p.x + o); nm[j] = *(const u32x2*)(mix + o); } }
#pragma unroll
        for (int j = 0; j < 8; ++j) { const f32x4 mv = (f32x4){bflo(mw[j].x), bfhi(mw[j].x), bflo(mw[j].y), bfhi(mw[j].y)};
            const f32x4 g = *(const f32x4*)(p.ln0_g + j * 256 + lane * 4), b = *(const f32x4*)(p.ln0_b + j * 256 + lane * 4);
            v[j] = ((v[j] - mean) * rstd * g + b) * ALPHA + mv; }
        ln_row(v, p.ln1_g, p.ln1_b, lane);
#pragma unroll
        for (int j = 0; j < 8; ++j) { const size_t o = (size_t)row * DM + j * 256 + lane * 4;
            u32x2 w; w.x = cvt_pk_bf16(v[j][0], v[j][1]); w.y = cvt_pk_bf16(v[j][2], v[j][3]); *(u32x2*)(h1b + o) = w; }
    }
}
__device__ __forceinline__ void ph_ln2(const Params& p) {
    const int tid = otid(), wid = tid >> 6, lane = tid & 63;
    float* h = (float*)(p.ws + WS_REGB); bf16_t* h2b = (bf16_t*)(p.ws + WS_REGC); const float* xat = p.out;
    for (int row = blockIdx.x * 8 + wid; row < T_TOK; row += gridDim.x * 8) {
        f32x4 v[8];
#pragma unroll
        for (int j = 0; j < 8; ++j) { const size_t o = (size_t)row * DM + j * 256 + lane * 4; v[j] = *(const f32x4*)(h + o) * ALPHA + *(const f32x4*)(xat + o); }
        ln_row(v, p.ln2_g, p.ln2_b, lane);
#pragma unroll
        for (int j = 0; j < 8; ++j) { const size_t o = (size_t)row * DM + j * 256 + lane * 4; *(f32x4*)(h + o) = v[j];
            u32x2 w; w.x = cvt_pk_bf16(v[j][0], v[j][1]); w.y = cvt_pk_bf16(v[j][2], v[j][3]); *(u32x2*)(h2b + o) = w; }
    }
}
__device__ __forceinline__ void ph_ln3(const Params& p) {
    const int tid = otid(), wid = tid >> 6, lane = tid & 63;
    const bf16_t* h = (const bf16_t*)(p.ws + WS_S2); const float* gates = (const float*)(p.ws + WS_GATES); const bf16_t* y2 = (const bf16_t*)p.out; const float* stats2 = (const float*)(p.ws + WS_STATS2);
    const int rstep = gridDim.x * 8; int row = blockIdx.x * 8 + wid;
    u32x2 nh[8]; u32x2 na[8], nb[8];
    if (row < T_TOK) {
#pragma unroll
        for (int j = 0; j < 8; ++j) { nh[j] = *(const u32x2*)(h + (size_t)row * DM + j * 256 + lane * 4); na[j] = *(const u32x2*)(y2 + (size_t)(2 * row) * DM + j * 256 + lane * 4); nb[j] = *(const u32x2*)(y2 + (size_t)(2 * row + 1) * DM + j * 256 + lane * 4); } }
    for (; row < T_TOK; row += rstep) {
        const float g0 = gates[row * 2], g1 = gates[row * 2 + 1], m2 = stats2[row * 2], r2 = stats2[row * 2 + 1] * ALPHA; f32x4 v[8];
#pragma unroll
        for (int j = 0; j < 8; ++j) { const f32x4 a = (f32x4){bflo(na[j].x), bfhi(na[j].x), bflo(na[j].y), bfhi(na[j].y)}, b = (f32x4){bflo(nb[j].x), bfhi(nb[j].x), bflo(nb[j].y), bfhi(nb[j].y)};
            const f32x4 gg = *(const f32x4*)(p.ln2_g + j * 256 + lane * 4), bb = *(const f32x4*)(p.ln2_b + j * 256 + lane * 4);
            v[j] = (((f32x4){bflo(nh[j].x), bfhi(nh[j].x), bflo(nh[j].y), bfhi(nh[j].y)} - m2) * r2) * gg + bb * ALPHA + (a * g0 + b * g1); }
        if (row + rstep < T_TOK) { const int rn = row + rstep;
#pragma unroll
            for (int j = 0; j < 8; ++j) { nh[j] = *(const u32x2*)(h + (size_t)rn * DM + j * 256 + lane * 4); na[j] = *(const u32x2*)(y2 + (size_t)(2 * rn) * DM + j * 256 + lane * 4); nb[j] = *(const u32x2*)(y2 + (size_t)(2 * rn + 1) * DM + j * 256 + lane * 4); } }
        ln_row(v, p.ln3_g, p.ln3_b, lane);
#pragma unroll
        for (int j = 0; j < 8; ++j) *(f32x4*)(p.out + (size_t)row * DM + j * 256 + lane * 4) = v[j];
    }
}


__device__ __forceinline__ int kperm(int k) { return (k & ~31) | (((k >> 2) & 3) << 3) | (((k >> 4) & 1) << 2) | (k & 3); }
__device__ __forceinline__ int img256(int row, int kp) { return row * 256 + ((((kp >> 3) ^ (row & 15))) << 4) + (kp & 7) * 2; }
__device__ __forceinline__ int img128(int row, int kp) { return row * 128 + ((((kp >> 3) ^ ((row >> 1) & 7))) << 4) + (kp & 7) * 2; }
__device__ __forceinline__ bf16x8 frag256(const LAS unsigned char* base, int R, int ch) { return *(const LAS bf16x8*)(base + R * 256 + ((ch ^ (R & 15)) << 4)); }
__device__ __forceinline__ bf16x8 frag128(const LAS unsigned char* base, int R, int ch) { return *(const LAS bf16x8*)(base + R * 128 + ((ch ^ ((R >> 1) & 7)) << 4)); }
__device__ __forceinline__ int img128x(int row, int kp) { return row * 128 + ((((kp >> 3) ^ ((row >> 1) & 7) ^ ((row >> 4) & 7))) << 4) + (kp & 7) * 2; }
__device__ __forceinline__ bf16x8 frag128x(const LAS unsigned char* base, int R, int ch) { return *(const LAS bf16x8*)(base + R * 128 + ((ch ^ ((R >> 1) & 7) ^ ((R >> 4) & 7)) << 4)); }
__device__ __forceinline__ bf16x8 pack8(const f32x4 x, const f32x4 y) { u32x4 w; w.x = cvt_pk_bf16(x[0], x[1]); w.y = cvt_pk_bf16(x[2], x[3]); w.z = cvt_pk_bf16(y[0], y[1]); w.w = cvt_pk_bf16(y[2], y[3]); return __builtin_bit_cast(bf16x8, w); }
constexpr size_t GD_HREC = 40960, GD_KREC = 32768, GD_KOFF = 160 * MiB, GD_GOFF = 224 * MiB;

__device__ __forceinline__ void unpack8(const u32x4 w, float (&x)[8]) { x[0] = bflo(w.x); x[1] = bfhi(w.x); x[2] = bflo(w.y); x[3] = bfhi(w.y); x[4] = bflo(w.z); x[5] = bfhi(w.z); x[6] = bflo(w.w); x[7] = bfhi(w.w); }
__device__ __forceinline__ void conv_unit(const Params& p, const int unit, const int slot) {
    const bf16_t* proj = (const bf16_t*)(p.ws + WS_REGB); bf16_t* qkvc = (bf16_t*)(p.ws + WS_W13T) + (size_t)(blockIdx.x * 2 + slot) * 64 * DM - (size_t)unit * 64 * DM; bf16_t* mixcat = (bf16_t*)(p.ws + WS_REGC);
    const float* ab = (const float*)(p.ws + WS_AB); float* gg = (float*)(p.ws + WS_GG); float* gb = (float*)(p.ws + WS_GB);
    {
        const int t0 = unit * 64, s0 = t0 % SEQ;
        {
            const int tid = otid(), oct = tid & 255, half = tid >> 8, c0 = oct * 8, tb = t0 + half * 32, sb = s0 + half * 32;
            float w[4][8];
#pragma unroll
            for (int j = 0; j < 4; ++j) { const f32x4 w0 = *(const f32x4*)(p.gdn_conv_w + j * 2048 + c0), w1 = *(const f32x4*)(p.gdn_conv_w + j * 2048 + c0 + 4);
#pragma unroll
                for (int i = 0; i < 4; ++i) { w[j][i] = w0[i]; w[j][4 + i] = w1[i]; } }
            const bf16_t* src = proj + (size_t)tb * NPROJ + 3072 + c0;
            u32x4 win[3];
#pragma unroll
            for (int j = 0; j < 3; ++j) { win[j] = (u32x4){0u, 0u, 0u, 0u}; if (sb - 3 + j >= 0) win[j] = *(const u32x4*)(src + (ptrdiff_t)(j - 3) * NPROJ); }
            const bool isqk = oct < 128; const float nscale = oct < 64 ? 0.08838834764831845f : 1.0f;
            for (int g8 = 0; g8 < 4; ++g8) {
                u32x4 row[8];
#pragma unroll
                for (int i = 0; i < 8; ++i) row[i] = *(const u32x4*)(src + (size_t)(g8 * 8 + i) * NPROJ);
#pragma unroll
                for (int i = 0; i < 8; ++i) {
                    float x0[8], x1[8], x2[8], x3[8];
                    unpack8(i >= 3 ? row[i - 3] : win[i], x0); unpack8(i >= 2 ? row[i - 2] : win[i + 1 > 2 ? 2 : i + 1], x1); unpack8(i >= 1 ? row[i - 1] : win[2], x2); unpack8(row[i], x3);
                    float acc[8]; float ss = 0.f;
#pragma unroll
                    for (int e = 0; e < 8; ++e) { acc[e] = silu_f(w[0][e] * x0[e] + w[1][e] * x1[e] + w[2][e] * x2[e] + w[3][e] * x3[e]); ss += acc[e] * acc[e]; }
                    if (isqk) { ss = dpp_row_sum(ss); const float r = rsqrtf(ss + 1e-6f) * nscale;
#pragma unroll
                        for (int e = 0; e < 8; ++e) acc[e] *= r; }
                    u32x4 o; o.x = cvt_pk_bf16(acc[0], acc[1]); o.y = cvt_pk_bf16(acc[2], acc[3]); o.z = cvt_pk_bf16(acc[4], acc[5]); o.w = cvt_pk_bf16(acc[6], acc[7]);
                    *(u32x4*)(qkvc + (size_t)(tb + g8 * 8 + i) * DM + c0) = o;
                }
                win[0] = row[5]; win[1] = row[6]; win[2] = row[7];
            }
        }
        {
            const int tid = otid(), oct = tid & 127, qr = tid >> 7, c0 = oct * 8, tb = t0 + qr * 16, sb = s0 + qr * 16;
            float w[3][8];
#pragma unroll
            for (int j = 0; j < 3; ++j) { const f32x4 w0 = *(const f32x4*)(p.sconv_w + j * 1024 + c0), w1 = *(const f32x4*)(p.sconv_w + j * 1024 + c0 + 4);
#pragma unroll
                for (int i = 0; i < 4; ++i) { w[j][i] = w0[i]; w[j][4 + i] = w1[i]; } }
            const bf16_t* src = proj + (size_t)tb * NPROJ + c0;
            float pm2[8], pm1[8];
            { float cv[8], xv[8];
#pragma unroll
                for (int e = 0; e < 8; ++e) { pm2[e] = 0.f; pm1[e] = 0.f; }
                if (sb - 2 >= 0) { unpack8(*(const u32x4*)(src - (ptrdiff_t)2 * NPROJ + 1024), cv); unpack8(*(const u32x4*)(src - (ptrdiff_t)2 * NPROJ + 2048), xv);
#pragma unroll
                    for (int e = 0; e < 8; ++e) pm2[e] = cv[e] * xv[e]; }
                if (sb - 1 >= 0) { unpack8(*(const u32x4*)(src - (ptrdiff_t)1 * NPROJ + 1024), cv); unpack8(*(const u32x4*)(src - (ptrdiff_t)1 * NPROJ + 2048), xv);
#pragma unroll
                    for (int e = 0; e < 8; ++e) pm1[e] = cv[e] * xv[e]; } }
            for (int g4 = 0; g4 < 4; ++g4) {
                u32x4 rb[4], rc[4], rx[4];
#pragma unroll
                for (int i = 0; i < 4; ++i) { const bf16_t* r = src + (size_t)(g4 * 4 + i) * NPROJ; rb[i] = *(const u32x4*)r; rc[i] = *(const u32x4*)(r + 1024); rx[i] = *(const u32x4*)(r + 2048); }
#pragma unroll
                for (int i = 0; i < 4; ++i) { float bv[8], cv[8], xv[8], pr[8], y[8]; unpack8(rb[i], bv); unpack8(rc[i], cv); unpack8(rx[i], xv);
#pragma unroll
                    for (int e = 0; e < 8; ++e) { pr[e] = cv[e] * xv[e]; y[e] = bv[e] * (w[0][e] * pm2[e] + w[1][e] * pm1[e] + w[2][e] * pr[e]); pm2[e] = pm1[e]; pm1[e] = pr[e]; }
                    u32x4 o; o.x = cvt_pk_bf16(y[0], y[1]); o.y = cvt_pk_bf16(y[2], y[3]); o.z = cvt_pk_bf16(y[4], y[5]); o.w = cvt_pk_bf16(y[6], y[7]);
                    *(u32x4*)(mixcat + (size_t)(tb + g4 * 4 + i) * DM + c0) = o; }
            }
        }
        {
            const int tid = otid(), t = t0 + (tid >> 3), h = tid & 7;
            const float a = ab[(size_t)t * 16 + h] + p.dt_bias[h], b = ab[(size_t)t * 16 + 8 + h];
            const float sp = a > 20.f ? a : log1pf(__expf(a));
            gg[(size_t)t * 8 + h] = -__expf(p.a_log[h]) * sp; gb[(size_t)t * 8 + h] = 1.0f / (1.0f + __expf(-b)); }
    }
}

__device__ __forceinline__ LAS unsigned char* st_addr(LAS unsigned char* lds, int off) { return lds + (off < 4096 ? 69632 + off : 139264 - 4096 + off); }
__device__ __forceinline__ void ph_gdn_prep(const Params& p, LAS unsigned char* lds) {
    const int wid = __builtin_amdgcn_readfirstlane(otid() >> 6);
    LAS float* Gs = (LAS float*)(lds); LAS float* Bs = (LAS float*)(lds + 2048);
    LAS float* KK = (LAS float*)(lds + 4096);
    LAS unsigned char* TM = lds + 4096;
    LAS unsigned char* KS = lds + 4096 + 69632; LAS unsigned char* QS = KS + 16384; LAS unsigned char* RTV = QS + 16384; LAS unsigned char* RTK = RTV + 16384;
    const float* gg = (const float*)(p.ws + WS_GG); const float* gb = (const float*)(p.ws + WS_GB);
    unsigned char* gd = (unsigned char*)p.out;
    const int nun = (512 - (int)blockIdx.x + (int)gridDim.x - 1) / (int)gridDim.x; const bool ahead = (blockIdx.x & 1) && nun == 2;
    for (int step = 0; step < 2 * nun; ++step) {
        const bool isconv = ahead ? (step < nun) : !(step & 1); const int kk = ahead ? (isconv ? step : step - nun) : (step >> 1), slot = kk & 1;
        const int unit = blockIdx.x + kk * gridDim.x;
        const int b = unit >> 8, n = unit & 255; const size_t t0 = (size_t)b * SEQ + (size_t)n * 64;
        const bf16_t* qkvc = (const bf16_t*)(p.ws + WS_W13T) + (size_t)(blockIdx.x * 2 + slot) * 64 * DM - t0 * DM;
        if (isconv) {
            conv_unit(p, unit, slot);
            asm volatile("s_waitcnt vmcnt(0)" ::: "memory");
            __syncthreads();
            if (otid() == 0) { __builtin_amdgcn_fence(__ATOMIC_ACQUIRE, "agent"); asm volatile("s_waitcnt vmcnt(0)" ::: "memory"); }
            __syncthreads();
            continue; }
        { const int lane = otid() & 63; const int h = wid; float g = gg[(t0 + lane) * 8 + h]; const float bt = gb[(t0 + lane) * 8 + h];
            g = wave_scan(g);
            Gs[h * 64 + lane] = g; Bs[h * 64 + lane] = bt;
            ((float*)(gd + GD_GOFF))[((size_t)(b * 8 + h) * 256 + n) * 64 + lane] = g; }
        for (int kh = 0; kh < 4; ++kh) {
            const int tidA = otid(), jrow = tidA >> 3, part = tidA & 7, m16 = tidA & 15, q4 = (tidA >> 4) & 3;
            { const bf16_t* src = qkvc + (t0 + jrow) * DM + 512 + kh * 128 + part * 16;
                const u32x4 a = *(const u32x4*)src, c = *(const u32x4*)(src + 8);
                *(LAS u32x4*)(KS + img256(jrow, part * 16)) = a; *(LAS u32x4*)(KS + img256(jrow, part * 16 + 8)) = c; }
            __syncthreads();
            { const int it = wid >> 1;
#pragma unroll
                for (int jj = 0; jj < 2; ++jj) { const int jt = (wid & 1) * 2 + jj; f32x4 acc = (f32x4){0.f, 0.f, 0.f, 0.f};
#pragma unroll
                    for (int s = 0; s < 4; ++s) acc = __builtin_amdgcn_mfma_f32_16x16x32_bf16(frag256(KS, 16 * it + m16, 4 * s + q4), frag256(KS, 16 * jt + m16, 4 * s + q4), acc, 0, 0, 0);
#pragma unroll
                    for (int r = 0; r < 4; ++r) KK[kh * 64 * 68 + (16 * it + 4 * q4 + r) * 68 + 16 * jt + m16] = acc[r]; } }
            __syncthreads();
        }
        float mcol[64];
        { const int h = wid, kh = h >> 1, c = otid() & 63; const float Gc_ = Gs[h * 64 + c];
#pragma unroll
            for (int j = 0; j < 64; ++j) { const float kkv = KK[kh * 64 * 68 + j * 68 + c]; const float v = -Bs[h * 64 + j] * kkv * __expf(Gs[h * 64 + j] - Gc_); mcol[j] = (j > c) ? v : 0.f; } }
        __syncthreads();
        {
#pragma unroll
            for (int i = 1; i < 64; ++i) { const int mi = __float_as_int(mcol[i]); float a0 = mcol[i], a1 = 0.f;
#pragma unroll
                for (int j = 0; j < i; ++j) { const float s = __int_as_float(__builtin_amdgcn_readlane(mi, j)); if (j & 1) a1 += s * mcol[j]; else a0 += s * mcol[j]; }
                mcol[i] = a0 + a1; }
            LAS unsigned char* TMh = TM + wid * 8192; const int lane = otid() & 63;
#pragma unroll
            for (int i = 0; i < 64; ++i) { const float v = (i > lane) ? mcol[i] : (i == lane ? 1.0f : 0.f); *(LAS bf16_t*)(TMh + img128(i, lane)) = (bf16_t)(cvt_pk_bf16(v, 0.f) & 0xffffu); }
        }
        __syncthreads();
        u32x4 va, vb, ka, kb, qa, qb;
        { const int tidC = otid(), jrow = tidC >> 3, part = tidC & 7; const bf16_t* rowp = qkvc + (t0 + jrow) * DM;
            va = *(const u32x4*)(rowp + 1024 + part * 16); vb = *(const u32x4*)(rowp + 1024 + part * 16 + 8);
            ka = *(const u32x4*)(rowp + 512 + part * 16); kb = *(const u32x4*)(rowp + 512 + part * 16 + 8);
            qa = *(const u32x4*)(rowp + part * 16); qb = *(const u32x4*)(rowp + part * 16 + 8); }
        for (int h = 0; h < 8; ++h) {
            const int kh = h >> 1; const int tidC = otid(), jrow = tidC >> 3, part = tidC & 7, lane = tidC & 63, m16 = tidC & 15, q4 = (tidC >> 4) & 3;
            unsigned char* hrec = gd + ((size_t)(b * 8 + h) * 256 + n) * GD_HREC; unsigned char* krec = gd + GD_KOFF + ((size_t)(b * 4 + kh) * 256 + n) * GD_KREC;
            { const float bj = Bs[h * 64 + jrow], be = bj * __expf(Gs[h * 64 + jrow]);
                if ((h & 1) == 0) {
                    *(LAS u32x4*)(KS + img256(jrow, part * 16)) = ka; *(LAS u32x4*)(KS + img256(jrow, part * 16 + 8)) = kb;
                    *(LAS u32x4*)(QS + img256(jrow, part * 16)) = qa; *(LAS u32x4*)(QS + img256(jrow, part * 16 + 8)) = qb; }
                const unsigned vw[8] = {va.x, va.y, va.z, va.w, vb.x, vb.y, vb.z, vb.w}, kw[8] = {ka.x, ka.y, ka.z, ka.w, kb.x, kb.y, kb.z, kb.w}, qw[8] = {qa.x, qa.y, qa.z, qa.w, qb.x, qb.y, qb.z, qb.w};
#pragma unroll
                for (int e = 0; e < 8; ++e) { const int c = part * 16 + 2 * e;
                    const unsigned pv = cvt_pk_bf16(bflo(vw[e]) * bj, bfhi(vw[e]) * bj), pk = cvt_pk_bf16(bflo(kw[e]) * be, bfhi(kw[e]) * be);
                    *(LAS bf16_t*)(RTV + img128x(c, jrow)) = (bf16_t)(pv & 0xffffu); *(LAS bf16_t*)(RTV + img128x(c + 1, jrow)) = (bf16_t)(pv >> 16);
                    *(LAS bf16_t*)(RTK + img128x(c, jrow)) = (bf16_t)(pk & 0xffffu); *(LAS bf16_t*)(RTK + img128x(c + 1, jrow)) = (bf16_t)(pk >> 16); }
                if ((h & 1) == 0) {
                    const int jp = kperm(jrow);
#pragma unroll
                    for (int e = 0; e < 4; ++e) { const int c = part * 16 + 4 * e; u32x2 w; w.x = qw[2 * e]; w.y = qw[2 * e + 1]; *(u32x2*)(krec + img256(jrow, kperm(c))) = w; }
#pragma unroll
                    for (int e = 0; e < 8; ++e) { const int c = part * 16 + 2 * e; *(LAS bf16_t*)st_addr(lds, img128(c, jp)) = (bf16_t)(kw[e] & 0xffffu); *(LAS bf16_t*)st_addr(lds, img128(c + 1, jp)) = (bf16_t)(kw[e] >> 16); }
                } }
            __syncthreads();
            if ((h & 1) == 0) {
                const u32x4 s0 = *(const LAS u32x4*)st_addr(lds, tidC * 32), s1 = *(const LAS u32x4*)st_addr(lds, tidC * 32 + 16);
                *(u32x4*)(krec + 16384 + tidC * 32) = s0; *(u32x4*)(krec + 16384 + tidC * 32 + 16) = s1; }
            if (h + 1 < 8) { const int h1 = h + 1, kh1 = h1 >> 1; const bf16_t* rowp = qkvc + (t0 + jrow) * DM;
                va = *(const u32x4*)(rowp + 1024 + h1 * 128 + part * 16); vb = *(const u32x4*)(rowp + 1024 + h1 * 128 + part * 16 + 8);
                if ((h1 & 1) == 0) { ka = *(const u32x4*)(rowp + 512 + kh1 * 128 + part * 16); kb = *(const u32x4*)(rowp + 512 + kh1 * 128 + part * 16 + 8);
                    qa = *(const u32x4*)(rowp + kh1 * 128 + part * 16); qb = *(const u32x4*)(rowp + kh1 * 128 + part * 16 + 8); } }
            const LAS unsigned char* TMh = TM + h * 8192;
            {
#pragma unroll
                for (int it = 0; it < 4; ++it) { f32x4 acc = (f32x4){0.f, 0.f, 0.f, 0.f};
#pragma unroll
                    for (int s = 0; s < 2; ++s) acc = __builtin_amdgcn_mfma_f32_16x16x32_bf16(frag128x(RTK, 16 * wid + m16, 4 * s + q4), frag128(TMh, 16 * it + m16, 4 * s + q4), acc, 0, 0, 0);
                    const int i = 16 * it + m16, kp0 = 32 * (wid >> 1) + 8 * q4 + 4 * (wid & 1);
                    u32x2 w; w.x = cvt_pk_bf16(-acc[0], -acc[1]); w.y = cvt_pk_bf16(-acc[2], -acc[3]); *(u32x2*)(hrec + img256(i, kp0)) = w; }
                unsigned uw[8];
#pragma unroll
                for (int rt = 0; rt < 4; ++rt) { f32x4 acc = (f32x4){0.f, 0.f, 0.f, 0.f};
#pragma unroll
                    for (int s = 0; s < 2; ++s) acc = __builtin_amdgcn_mfma_f32_16x16x32_bf16(frag128(TMh, 16 * rt + m16, 4 * s + q4), frag128x(RTV, 16 * wid + m16, 4 * s + q4), acc, 0, 0, 0);
                    uw[2 * rt] = cvt_pk_bf16(acc[0], acc[1]); uw[2 * rt + 1] = cvt_pk_bf16(acc[2], acc[3]); }
                { u32x4 w0, w1; w0.x = uw[0]; w0.y = uw[1]; w0.z = uw[2]; w0.w = uw[3]; w1.x = uw[4]; w1.y = uw[5]; w1.z = uw[6]; w1.w = uw[7];
                  unsigned char* up = hrec + 24576 + (size_t)(wid * 64 + lane) * 32; *(u32x4*)up = w0; *(u32x4*)(up + 16) = w1; }
                const int it = wid >> 1, i = 16 * it + m16; const float Gi = Gs[h * 64 + i];
#pragma unroll
                for (int jj = 0; jj < 2; ++jj) { const int jt = (wid & 1) * 2 + jj; f32x4 acc = (f32x4){0.f, 0.f, 0.f, 0.f};
#pragma unroll
                    for (int s = 0; s < 4; ++s) acc = __builtin_amdgcn_mfma_f32_16x16x32_bf16(frag256(KS, 16 * jt + m16, 4 * s + q4), frag256(QS, 16 * it + m16, 4 * s + q4), acc, 0, 0, 0);
                    float v[4];
#pragma unroll
                    for (int r = 0; r < 4; ++r) { const int j = 16 * jt + 4 * q4 + r; v[r] = (j <= i) ? acc[r] * __expf(Gi - Gs[h * 64 + j]) : 0.f; }
                    const int kp0 = 32 * (jt >> 1) + 8 * q4 + 4 * (jt & 1);
                    u32x2 w; w.x = cvt_pk_bf16(v[0], v[1]); w.y = cvt_pk_bf16(v[2], v[3]); *(u32x2*)(hrec + 16384 + img128(i, kp0)) = w; }
            }
            __syncthreads();
        }
    }
}

constexpr size_t SC_PIMG = 225 * MiB, SC_QF = 233 * MiB;
#define GD_UNPACK_U(av, ua, ub) do { av[0] = (f32x4){bflo(ua.x), bfhi(ua.x), bflo(ua.y), bfhi(ua.y)}; av[1] = (f32x4){bflo(ua.z), bfhi(ua.z), bflo(ua.w), bfhi(ua.w)}; \
        av[2] = (f32x4){bflo(ub.x), bfhi(ub.x), bflo(ub.y), bfhi(ub.y)}; av[3] = (f32x4){bflo(ub.z), bfhi(ub.z), bflo(ub.w), bfhi(ub.w)}; } while (0)

__device__ __forceinline__ void ph_gdn_passA(const Params& p, LAS unsigned char* lds) {
    const int tid = otid(), wid = __builtin_amdgcn_readfirstlane(tid >> 6), lane = tid & 63, m16 = lane & 15, q4 = lane >> 4;
    const unsigned char* gd = (const unsigned char*)p.out;
    for (int id = blockIdx.x; id < 256; id += gridDim.x) {
        const int b = id >> 7, h = (id >> 4) & 7, kh = h >> 1, n0 = (id & 15) * 16;
        const unsigned char* hrec0 = gd + ((size_t)(b * 8 + h) * 256 + n0) * GD_HREC; const unsigned char* krec0 = gd + GD_KOFF + ((size_t)(b * 4 + kh) * 256 + n0) * GD_KREC;
        const float* Gc0 = (const float*)(gd + GD_GOFF) + ((size_t)(b * 8 + h) * 256 + n0) * 64;
        constexpr int BUFA = 32768;
#define GA_DMA(nn, bufi) do { const unsigned char* _hr = hrec0 + (size_t)(nn) * GD_HREC; const unsigned char* _kr = krec0 + (size_t)(nn) * GD_KREC + 16384; \
        _Pragma("unroll") for (int _k = 0; _k < 4; ++_k) { const int _pc = wid + 8 * _k; const unsigned char* _src = (_pc < 16 ? _hr + _pc * 1024 : _kr + (_pc - 16) * 1024) + lane * 16; \
            __builtin_amdgcn_global_load_lds((const unsigned*)_src, (LAS unsigned*)(lds + (bufi) * BUFA + _pc * 1024), 16, 0, 0); } } while (0)
        f32x4 Ps[8], Qs[8]; const int lz = otid() & 63, mz = lz & 15, qz = lz >> 4;
#pragma unroll
        for (int a = 0; a < 8; ++a) { Qs[a] = (f32x4){0.f, 0.f, 0.f, 0.f};
#pragma unroll
            for (int r = 0; r < 4; ++r) Ps[a][r] = (16 * a + 4 * qz + r == 16 * wid + mz) ? 1.0f : 0.f; }
        GA_DMA(0, 0);
        u32x4 ua = *(const u32x4*)(hrec0 + 24576 + (size_t)(wid * 64 + lane) * 32), ub = *(const u32x4*)(hrec0 + 24576 + (size_t)(wid * 64 + lane) * 32 + 16);
        f32x4 gv[4]; float G63 = Gc0[63];
#pragma unroll
        for (int rt = 0; rt < 4; ++rt) gv[rt] = *(const f32x4*)(Gc0 + 16 * rt + 4 * q4);
        GA_DMA(1, 1);
        for (int n = 0; n < 16; ++n) {
            const int cur = n % 3, nn = (n + 1 < 16) ? n + 1 : n;
            if (n + 1 < 16) asm volatile("s_waitcnt vmcnt(4)" ::: "memory"); else asm volatile("s_waitcnt vmcnt(0)" ::: "memory");
            __builtin_amdgcn_s_barrier();
            const unsigned char* hrn = hrec0 + (size_t)nn * GD_HREC; const float* Gn = Gc0 + (size_t)nn * 64;
            const u32x4 ua_n = *(const u32x4*)(hrn + 24576 + (size_t)(wid * 64 + lane) * 32), ub_n = *(const u32x4*)(hrn + 24576 + (size_t)(wid * 64 + lane) * 32 + 16);
            f32x4 gv_n[4]; const float G63_n = Gn[63];
#pragma unroll
            for (int rt = 0; rt < 4; ++rt) gv_n[rt] = *(const f32x4*)(Gn + 16 * rt + 4 * q4);
            asm volatile("" ::: "memory");
            if (n + 2 < 16) GA_DMA(n + 2, (n + 2) % 3);
            const LAS unsigned char* WN = lds + cur * BUFA; const LAS unsigned char* KT = WN + 16384;
            f32x4 ek[4];
#pragma unroll
            for (int rt = 0; rt < 4; ++rt) {
#pragma unroll
                for (int r = 0; r < 4; ++r) ek[rt][r] = __expf(G63 - gv[rt][r]); }
            const float gam = __expf(G63);
            bf16x8 SBp[4], SBq[4];
#pragma unroll
            for (int s = 0; s < 4; ++s) { SBp[s] = pack8(Ps[2 * s], Ps[2 * s + 1]); SBq[s] = pack8(Qs[2 * s], Qs[2 * s + 1]); }
            f32x4 vp[4], vq[4]; GD_UNPACK_U(vq, ua, ub);
#pragma unroll
            for (int rt = 0; rt < 4; ++rt) { vp[rt] = (f32x4){0.f, 0.f, 0.f, 0.f};
#pragma unroll
                for (int s = 0; s < 4; ++s) { const bf16x8 wf = frag256(WN, 16 * rt + m16, 4 * s + q4);
                    vp[rt] = __builtin_amdgcn_mfma_f32_16x16x32_bf16(wf, SBp[s], vp[rt], 0, 0, 0); vq[rt] = __builtin_amdgcn_mfma_f32_16x16x32_bf16(wf, SBq[s], vq[rt], 0, 0, 0); } }
            bf16x8 VBp[2], VBq[2];
#pragma unroll
            for (int s2 = 0; s2 < 2; ++s2) { VBp[s2] = pack8(vp[2 * s2] * ek[2 * s2], vp[2 * s2 + 1] * ek[2 * s2 + 1]); VBq[s2] = pack8(vq[2 * s2] * ek[2 * s2], vq[2 * s2 + 1] * ek[2 * s2 + 1]); }
#pragma unroll
            for (int a = 0; a < 8; ++a) { Ps[a] = Ps[a] * gam; Qs[a] = Qs[a] * gam;
#pragma unroll
                for (int s2 = 0; s2 < 2; ++s2) { const bf16x8 kf = frag128(KT, 16 * a + m16, 4 * s2 + q4);
                    Ps[a] = __builtin_amdgcn_mfma_f32_16x16x32_bf16(kf, VBp[s2], Ps[a], 0, 0, 0); Qs[a] = __builtin_amdgcn_mfma_f32_16x16x32_bf16(kf, VBq[s2], Qs[a], 0, 0, 0); } }
            ua = ua_n; ub = ub_n; G63 = G63_n;
#pragma unroll
            for (int rt = 0; rt < 4; ++rt) gv[rt] = gv_n[rt];
        }
        unsigned char* pimg = (unsigned char*)p.out + SC_PIMG + (size_t)id * 32768; f32x4* qf = (f32x4*)((unsigned char*)p.out + SC_QF + (size_t)id * 65536);
        const int le = otid() & 63, kp = kperm(16 * wid + (le & 15));
#pragma unroll
        for (int a = 0; a < 8; ++a) { qf[(wid * 8 + a) * 64 + le] = Qs[a];
#pragma unroll
            for (int r = 0; r < 4; r += 2) { const unsigned w = cvt_pk_bf16(Ps[a][r], Ps[a][r + 1]); const int kf = 16 * a + 4 * (le >> 4) + r;
                *(bf16_t*)(pimg + img256(kf, kp)) = (bf16_t)(w & 0xffffu); *(bf16_t*)(pimg + img256(kf + 1, kp)) = (bf16_t)(w >> 16); } }
        asm volatile("s_waitcnt vmcnt(0)" ::: "memory"); __syncthreads();
#undef GA_DMA
    }
}
__device__ __forceinline__ void ph_gdn_combine(const Params& p, LAS unsigned char* lds) {
    const int tid = otid(), wid = __builtin_amdgcn_readfirstlane(tid >> 6), lane = tid & 63, m16 = lane & 15, q4 = lane >> 4;
    const int bh = blockIdx.x;
    const unsigned char* pimg0 = (const unsigned char*)p.out + SC_PIMG + (size_t)bh * 16 * 32768; const f32x4* qf0 = (const f32x4*)((const unsigned char*)p.out + SC_QF + (size_t)bh * 16 * 65536);
    f32x4* sin0 = (f32x4*)(p.ws + WS_SIN + (size_t)bh * 16 * 65536);
#define GC_DMA(sg, bufi) do { _Pragma("unroll") for (int _k = 0; _k < 4; ++_k) { const int _pc = wid + 8 * _k; \
        __builtin_amdgcn_global_load_lds((const unsigned*)(pimg0 + (size_t)(sg) * 32768 + _pc * 1024 + lane * 16), (LAS unsigned*)(lds + (bufi) * 32768 + _pc * 1024), 16, 0, 0); } } while (0)
    f32x4 S[8];
#pragma unroll
    for (int a = 0; a < 8; ++a) S[a] = (f32x4){0.f, 0.f, 0.f, 0.f};
    GC_DMA(0, 0);
    for (int sg = 0; sg < 16; ++sg) {
        const int cur = sg & 1;
        f32x4 qv[8];
#pragma unroll
        for (int a = 0; a < 8; ++a) { sin0[((size_t)sg * 64 + wid * 8 + a) * 64 + lane] = S[a]; qv[a] = qf0[((size_t)sg * 64 + wid * 8 + a) * 64 + lane]; }
        asm volatile("s_waitcnt vmcnt(0)" ::: "memory"); __builtin_amdgcn_s_barrier();
        if (sg + 1 < 16) GC_DMA(sg + 1, cur ^ 1);
        const LAS unsigned char* PI = lds + cur * 32768;
        bf16x8 SB[4];
#pragma unroll
        for (int s = 0; s < 4; ++s) SB[s] = pack8(S[2 * s], S[2 * s + 1]);
#pragma unroll
        for (int a = 0; a < 8; ++a) { f32x4 acc = qv[a];
#pragma unroll
            for (int s = 0; s < 4; ++s) acc = __builtin_amdgcn_mfma_f32_16x16x32_bf16(frag256(PI, 16 * a + m16, 4 * s + q4), SB[s], acc, 0, 0, 0);
            S[a] = acc; }
    }
    asm volatile("s_waitcnt vmcnt(0)" ::: "memory"); __syncthreads();
#undef GC_DMA
}
__device__ __forceinline__ void ph_gdn_passB(const Params& p, LAS unsigned char* lds) {
    const int tid = otid(), wid = __builtin_amdgcn_readfirstlane(tid >> 6), lane = tid & 63, m16 = lane & 15, q4 = lane >> 4;
    const unsigned char* gd = (const unsigned char*)p.out;
    const bf16_t* proj = (const bf16_t*)(p.ws + WS_REGB); bf16_t* mixcat = (bf16_t*)(p.ws + WS_REGC);
    constexpr int BUFB = 57344;
    LAS float* red = (LAS float*)(lds + 2 * BUFB + 32768);
    for (int id = blockIdx.x; id < 256; id += gridDim.x) {
        const int b = id >> 7, h = (id >> 4) & 7, kh = h >> 1, n0 = (id & 15) * 16;
        const unsigned char* hrec0 = gd + ((size_t)(b * 8 + h) * 256 + n0) * GD_HREC; const unsigned char* krec0 = gd + GD_KOFF + ((size_t)(b * 4 + kh) * 256 + n0) * GD_KREC;
        const float* Gc0 = (const float*)(gd + GD_GOFF) + ((size_t)(b * 8 + h) * 256 + n0) * 64;
        const f32x4* sin = (const f32x4*)(p.ws + WS_SIN + (size_t)id * 65536);
        const float nw = p.norm_w[16 * wid + m16];
#define GD_DMA(nn, bufi) do { const unsigned char* _hr = hrec0 + (size_t)(nn) * GD_HREC; const unsigned char* _kr = krec0 + (size_t)(nn) * GD_KREC; \
        _Pragma("unroll") for (int _k = 0; _k < 7; ++_k) { const int _pc = wid + 8 * _k; const unsigned char* _src = (_pc < 24 ? _hr + _pc * 1024 : _kr + (_pc - 24) * 1024) + lane * 16; \
            __builtin_amdgcn_global_load_lds((const unsigned*)_src, (LAS unsigned*)(lds + (bufi) * BUFB + _pc * 1024), 16, 0, 0); } } while (0)
        f32x4 S[8];
#pragma unroll
        for (int a = 0; a < 8; ++a) S[a] = sin[(wid * 8 + a) * 64 + lane];
#define GZ_DMA(nn) do { const size_t _tb = (size_t)b * SEQ + (size_t)(n0 + (nn)) * 64; LAS unsigned char* _zb = lds + 2 * BUFB + ((nn) & 1) * 16384; \
        _Pragma("unroll") for (int _k2 = 0; _k2 < 2; ++_k2) { const int _pc = wid + 8 * _k2; \
            __builtin_amdgcn_global_load_lds((const unsigned*)(proj + (_tb + 4 * _pc + (lane >> 4)) * NPROJ + 5120 + h * 128 + (lane & 15) * 8), (LAS unsigned*)(_zb + _pc * 1024), 16, 0, 0); } } while (0)
        GD_DMA(0, 0); GD_DMA(1, 1); GZ_DMA(0);
        u32x4 ua = *(const u32x4*)(hrec0 + 24576 + (size_t)(wid * 64 + lane) * 32), ub = *(const u32x4*)(hrec0 + 24576 + (size_t)(wid * 64 + lane) * 32 + 16);
        f32x4 gv[4]; float G63 = Gc0[63];
#pragma unroll
        for (int rt = 0; rt < 4; ++rt) gv[rt] = *(const f32x4*)(Gc0 + 16 * rt + 4 * q4);
        asm volatile("s_waitcnt vmcnt(0)" ::: "memory"); __syncthreads();
        for (int n = 0; n < 16; ++n) {
            const int cur = n & 1, nn = (n + 1 < 16) ? n + 1 : n;
            const unsigned char* hrn = hrec0 + (size_t)nn * GD_HREC; const float* Gn = Gc0 + (size_t)nn * 64;
            const u32x4 ua_n = *(const u32x4*)(hrn + 24576 + (size_t)(wid * 64 + lane) * 32), ub_n = *(const u32x4*)(hrn + 24576 + (size_t)(wid * 64 + lane) * 32 + 16);
            f32x4 gv_n[4]; const float G63_n = Gn[63];
#pragma unroll
            for (int rt = 0; rt < 4; ++rt) gv_n[rt] = *(const f32x4*)(Gn + 16 * rt + 4 * q4);
            const size_t tbase = (size_t)b * SEQ + (size_t)(n0 + n) * 64;
            LAS unsigned char* zb = lds + 2 * BUFB + cur * 16384;
            const LAS unsigned char* WN = lds + cur * BUFB; const LAS unsigned char* AT = WN + 16384; const LAS unsigned char* QI = WN + 24576; const LAS unsigned char* KT = WN + 40960;
            f32x4 eg[4], ek[4];
#pragma unroll
            for (int rt = 0; rt < 4; ++rt) {
#pragma unroll
                for (int r = 0; r < 4; ++r) { eg[rt][r] = __expf(gv[rt][r]); ek[rt][r] = __expf(G63 - gv[rt][r]); } }
            const float gam = __expf(G63);
            bf16x8 SB[4];
#pragma unroll
            for (int s = 0; s < 4; ++s) SB[s] = pack8(S[2 * s], S[2 * s + 1]);
            f32x4 av[4]; GD_UNPACK_U(av, ua, ub);
#pragma unroll
            for (int rt = 0; rt < 4; ++rt)
#pragma unroll
                for (int s = 0; s < 4; ++s) av[rt] = __builtin_amdgcn_mfma_f32_16x16x32_bf16(frag256(WN, 16 * rt + m16, 4 * s + q4), SB[s], av[rt], 0, 0, 0);
            bf16x8 VB[2], VBs[2];
#pragma unroll
            for (int s2 = 0; s2 < 2; ++s2) { VB[s2] = pack8(av[2 * s2], av[2 * s2 + 1]); VBs[s2] = pack8(av[2 * s2] * ek[2 * s2], av[2 * s2 + 1] * ek[2 * s2 + 1]); }
            f32x4 ov[4];
#pragma unroll
            for (int rt = 0; rt < 4; ++rt) { f32x4 o1 = (f32x4){0.f, 0.f, 0.f, 0.f}, o2 = (f32x4){0.f, 0.f, 0.f, 0.f};
#pragma unroll
                for (int s = 0; s < 4; ++s) o1 = __builtin_amdgcn_mfma_f32_16x16x32_bf16(frag256(QI, 16 * rt + m16, 4 * s + q4), SB[s], o1, 0, 0, 0);
#pragma unroll
                for (int s2 = 0; s2 < 2; ++s2) o2 = __builtin_amdgcn_mfma_f32_16x16x32_bf16(frag128(AT, 16 * rt + m16, 4 * s2 + q4), VB[s2], o2, 0, 0, 0);
                ov[rt] = o1 * eg[rt] + o2; }
#pragma unroll
            for (int a = 0; a < 8; ++a) { S[a] = S[a] * gam;
#pragma unroll
                for (int s2 = 0; s2 < 2; ++s2) S[a] = __builtin_amdgcn_mfma_f32_16x16x32_bf16(frag128(KT, 16 * a + m16, 4 * s2 + q4), VBs[s2], S[a], 0, 0, 0); }
#pragma unroll
            for (int rt = 0; rt < 4; ++rt)
#pragma unroll
                for (int r = 0; r < 4; ++r) { const float ss = dpp_row_sum(ov[rt][r] * ov[rt][r]); if (m16 == 0) red[(16 * rt + 4 * q4 + r) * 8 + wid] = ss; }
            asm volatile("s_waitcnt vmcnt(0) lgkmcnt(0)" ::: "memory");
            __builtin_amdgcn_s_barrier();
            if (n + 2 < 16) GD_DMA(n + 2, cur);
            if (n + 1 < 16) GZ_DMA(n + 1);
#pragma unroll
            for (int rt = 0; rt < 4; ++rt)
#pragma unroll
                for (int r = 0; r < 4; ++r) { const int tk = 16 * rt + 4 * q4 + r; const f32x4 p0 = *(const LAS f32x4*)(red + tk * 8), p1 = *(const LAS f32x4*)(red + tk * 8 + 4);
                    const float ms = ((p0[0] + p0[1]) + (p0[2] + p0[3]) + (p1[0] + p1[1]) + (p1[2] + p1[3])) * (1.0f / 128.0f);
                    LAS bf16_t* zp = (LAS bf16_t*)(zb + tk * 256 + (16 * wid + m16) * 2);
                    const float zf = __uint_as_float(((unsigned)*zp) << 16);
                    const float y = ov[rt][r] * rsqrtf(ms + 1e-6f) * nw * silu_f(zf);
                    *zp = (bf16_t)(cvt_pk_bf16(y, 0.f) & 0xffffu); }
            asm volatile("s_waitcnt lgkmcnt(0)" ::: "memory");
            __builtin_amdgcn_s_barrier();
            { const int tok = tid >> 3, part = tid & 7;
                const u32x4 y0 = *(const LAS u32x4*)(zb + tok * 256 + part * 32), y1 = *(const LAS u32x4*)(zb + tok * 256 + part * 32 + 16);
                bf16_t* dst = mixcat + (tbase + tok) * DM + 1024 + h * 128 + part * 16;
                *(u32x4*)dst = y0; *(u32x4*)(dst + 8) = y1; }
            ua = ua_n; ub = ub_n; G63 = G63_n;
#pragma unroll
            for (int rt = 0; rt < 4; ++rt) gv[rt] = gv_n[rt];
        }
        asm volatile("s_waitcnt vmcnt(0)" ::: "memory"); __syncthreads();
#undef GD_DMA
#undef GZ_DMA
    }
}


__device__ __forceinline__ void ph_wr_frag(const Params& p) {
    const int tid = otid();
    for (int it = blockIdx.x * NTHR + tid; it < 64 * 5 * 2 * 64; it += gridDim.x * NTHR) {
        const int lane = it & 63, part = (it >> 6) & 1, sc = it >> 7, ct = sc % 5, s = sc / 5;
        const int c = 16 * ct + (lane & 15), k0 = 32 * s + 8 * (lane >> 4);
        float w[8];
#pragma unroll
        for (int j = 0; j < 8; ++j) { const int k = k0 + j; w[j] = c < 8 ? p.w_group[k * 8 + c] : (c < 72 ? p.w_router[k * 64 + (c - 8)] : 0.f); }
        { float sg = 0.f, sb = 0.f;
#pragma unroll
          for (int j = 0; j < 8; ++j) { sb += p.ln2_b[k0 + j] * w[j]; w[j] *= p.ln2_g[k0 + j]; sg += w[j]; }
          (void)sg; (void)sb; }
        unsigned hw[4];
#pragma unroll
        for (int j = 0; j < 4; ++j) hw[j] = cvt_pk_bf16(w[2 * j], w[2 * j + 1]);
        u32x4 o;
        if (part == 0) { o.x = hw[0]; o.y = hw[1]; o.z = hw[2]; o.w = hw[3]; }
        else { o.x = cvt_pk_bf16(w[0] - bflo(hw[0]), w[1] - bfhi(hw[0])); o.y = cvt_pk_bf16(w[2] - bflo(hw[1]), w[3] - bfhi(hw[1]));
               o.z = cvt_pk_bf16(w[4] - bflo(hw[2]), w[5] - bfhi(hw[2])); o.w = cvt_pk_bf16(w[6] - bflo(hw[3]), w[7] - bfhi(hw[3])); }
        *(u32x4*)(p.ws + WS_WRF + (size_t)it * 16) = o;
    }
}
__device__ __forceinline__ void ph_ln2_router(const Params& p, LAS unsigned char* lds) {
    const int tid = otid(), wid = __builtin_amdgcn_readfirstlane(tid >> 6), lane = tid & 63, m16 = lane & 15, q4 = lane >> 4;
    const bf16_t* s2 = (const bf16_t*)(p.ws + WS_S2); float* stats2 = (float*)(p.ws + WS_STATS2);
    const unsigned char* wrf = p.ws + WS_WRF; const float* part2 = (const float*)(p.ws + WS_PART2); const float* GR = (const float*)(p.ws + WS_CTL + CTL_GR); const float* BR = (const float*)(p.ws + WS_CTL + CTL_BR);
    float* gates = (float*)(p.ws + WS_GATES); int* slot = (int*)(p.ws + WS_SLOT); int* counts = (int*)(p.ws + WS_CTL + CTL_COUNTS);
    constexpr int CHB = 40960;
    LAS int* lcnt = (LAS int*)(lds + 2 * CHB + 8 * 5632); LAS int* lbase = lcnt + NEXP;
    if (tid < NEXP) lcnt[tid] = 0;
    __syncthreads();
#define RT_DMA(ch, bufi) do { _Pragma("unroll") for (int _k = 0; _k < 5; ++_k) { const int _pc = wid + 8 * _k; \
        __builtin_amdgcn_global_load_lds((const unsigned*)(wrf + (size_t)(ch) * CHB + _pc * 1024 + lane * 16), (LAS unsigned*)(lds + (bufi) * CHB + _pc * 1024), 16, 0, 0); } } while (0)
    for (int blk = blockIdx.x; blk < T_TOK / 128; blk += gridDim.x) {
        const int row0 = blk * 128 + wid * 16;
        float m2 = 0.f, r2 = 0.f;
#pragma unroll 4
        for (int i = 0; i < 16; ++i) { const f32x2 pp = *(const f32x2*)(part2 + ((size_t)(row0 + i) * 32 + (lane & 31)) * 2); const float ss = wave_sum(lane < 32 ? pp.x : 0.f), qq = wave_sum(lane < 32 ? pp.y : 0.f);
            const float mm = ss * (1.0f / DM), rr = rsqrtf(fmaxf(qq * (1.0f / DM) - mm * mm, 0.f) + 1e-5f); if (lane == i) { m2 = mm; r2 = rr; } }
        if (lane < 16) *(f32x2*)(stats2 + (size_t)(row0 + lane) * 2) = (f32x2){m2, r2};
        m2 = __int_as_float(__builtin_amdgcn_ds_bpermute(m16 * 4, __float_as_int(m2))); r2 = __int_as_float(__builtin_amdgcn_ds_bpermute(m16 * 4, __float_as_int(r2)));
        RT_DMA(0, 0);
        f32x4 acc[5];
#pragma unroll
        for (int ct = 0; ct < 5; ++ct) acc[ct] = (f32x4){0.f, 0.f, 0.f, 0.f};
        const bf16_t* arow = s2 + (size_t)(row0 + m16) * DM + 8 * q4;
        bf16x8 aq[3][4];
#pragma unroll
        for (int c2 = 0; c2 < 2; ++c2)
#pragma unroll
            for (int ks = 0; ks < 4; ++ks) aq[c2][ks] = *(const bf16x8*)(arow + 32 * (c2 * 4 + ks));
        __builtin_amdgcn_s_waitcnt(0x0F74); __syncthreads();
#pragma unroll 1
        for (int g3 = 0; g3 < 6; ++g3)
#pragma unroll
        for (int i3 = 0; i3 < 3; ++i3) { const int ch = g3 * 3 + i3; if (ch >= 16) break;
            if (ch + 1 < 16) RT_DMA(ch + 1, (ch + 1) & 1);
            if (ch + 2 < 16) {
#pragma unroll
                for (int ks = 0; ks < 4; ++ks) aq[(i3 + 2) % 3][ks] = *(const bf16x8*)(arow + 32 * ((ch + 2) * 4 + ks)); }
            const LAS unsigned char* wb = lds + (ch & 1) * CHB;
#pragma unroll
            for (int ks = 0; ks < 4; ++ks) {
#pragma unroll
                for (int ct = 0; ct < 5; ++ct) { const bf16x8 Whi = *(const LAS bf16x8*)(wb + ((ks * 5 + ct) * 2 + 0) * 1024 + lane * 16), Wlo = *(const LAS bf16x8*)(wb + ((ks * 5 + ct) * 2 + 1) * 1024 + lane * 16);
                    acc[ct] = __builtin_amdgcn_mfma_f32_16x16x32_bf16(Whi, aq[i3][ks], acc[ct], 0, 0, 0);
                    acc[ct] = __builtin_amdgcn_mfma_f32_16x16x32_bf16(Wlo, aq[i3][ks], acc[ct], 0, 0, 0); } }
            if (ch + 2 < 16) __builtin_amdgcn_s_waitcnt(0x0F74); else __builtin_amdgcn_s_waitcnt(0x0F70);
            __syncthreads();
        }
        LAS float* tl = (LAS float*)(lds + 2 * CHB + wid * 5632);
#pragma unroll
        for (int ct = 0; ct < 5; ++ct) { const f32x4 gr = *(const f32x4*)(GR + 16 * ct + 4 * q4), br = *(const f32x4*)(BR + 16 * ct + 4 * q4);
            *(LAS f32x4*)(tl + m16 * 88 + 16 * ct + 4 * q4) = (acc[ct] - gr * m2) * r2 + br; }
        asm volatile("s_waitcnt lgkmcnt(0)" ::: "memory");
        int ex0 = 0, ex1 = 0, lp0 = 0, lp1 = 0;
        if (lane < 16) { const int t = row0 + lane; const LAS float* l = tl + lane * 88;
            int g = 0; float gm = l[0];
            for (int i = 1; i < 8; ++i) { const float x = l[i]; if (x > gm) { gm = x; g = i; } }
            float gs = 0.f; for (int i = 0; i < 8; ++i) gs += __expf(l[i] - gm);
            const float gprob = 1.0f / gs;
            const LAS float* el = l + 8 + g * 8;
            int i0 = 0; float m0 = el[0];
            for (int i = 1; i < 8; ++i) { const float x = el[i]; if (x > m0) { m0 = x; i0 = i; } }
            int i1 = -1; float m1 = -3.0e38f;
            for (int i = 0; i < 8; ++i) { const float x = el[i]; if (i != i0 && x > m1) { m1 = x; i1 = i; } }
            const float e1 = __expf(m1 - m0), den = 1.0f + e1;
            gates[t * 2] = gprob / den; gates[t * 2 + 1] = gprob * e1 / den;
            ex0 = g * 8 + i0; ex1 = g * 8 + i1;
            lp0 = atomicAdd((int*)&lcnt[ex0], 1); lp1 = atomicAdd((int*)&lcnt[ex1], 1); }
        __syncthreads();
        if (tid < NEXP) { const int n = lcnt[tid]; lbase[tid] = n ? atomicAdd(&counts[tid], n) : 0; }
        __syncthreads();
        if (lane < 16) { const int t = row0 + lane; slot[(size_t)ex0 * CAP + lbase[ex0] + lp0] = 2 * t; slot[(size_t)ex1 * CAP + lbase[ex1] + lp1] = 2 * t + 1; }
        __syncthreads();
        if (tid < NEXP) lcnt[tid] = 0;
        __syncthreads();
    }
#undef RT_DMA
}

__device__ __forceinline__ void ph_gnorm(const Params& p) {
    const float* of = (const float*)(p.ws + WS_REGA); const bf16_t* proj = (const bf16_t*)(p.ws + WS_REGB); bf16_t* mixcat = (bf16_t*)(p.ws + WS_REGC);
    const int tid = otid(), lane = tid & 63, wv = blockIdx.x * 8 + (tid >> 6), nw = gridDim.x * 8;
    for (int i = wv; i < T_TOK * 8; i += nw) { const int t = i >> 3, h = i & 7;
        const f32x2 o = *(const f32x2*)(of + (size_t)t * 1024 + h * 128 + lane * 2);
        const float ms = wave_sum(o.x * o.x + o.y * o.y) * (1.0f / 128.0f), r = rsqrtf(ms + 1e-6f);
        const unsigned zw = *(const unsigned*)(proj + (size_t)t * NPROJ + 5120 + h * 128 + lane * 2);
        const float y0 = o.x * r * p.norm_w[lane * 2] * silu_f(bflo(zw)), y1 = o.y * r * p.norm_w[lane * 2 + 1] * silu_f(bfhi(zw));
        *(unsigned*)(mixcat + (size_t)t * DM + 1024 + h * 128 + lane * 2) = cvt_pk_bf16(y0, y1); }
}

__device__ __forceinline__ void ph_grbr(const Params& p) {
    const int c = blockIdx.x; if (c >= 72) return;
    const int tid = otid(), wid = tid >> 6, lane = tid & 63, k0 = wid * 256 + lane * 4;
    const f32x4 g = *(const f32x4*)(p.ln2_g + k0), b = *(const f32x4*)(p.ln2_b + k0); float sg = 0.f, sb = 0.f;
#pragma unroll
    for (int i = 0; i < 4; ++i) { const int k = k0 + i; const float w = c < 8 ? p.w_group[k * 8 + c] : p.w_router[k * 64 + (c - 8)]; sg += g[i] * w; sb += b[i] * w; }
    sg = wave_sum(sg); sb = wave_sum(sb);
    if (lane == 0) { atomicAdd((float*)(p.ws + WS_CTL + CTL_GR) + c, sg); atomicAdd((float*)(p.ws + WS_CTL + CTL_BR) + c, sb); }
}
__device__ __forceinline__ void ph_wq2(const Params& p) {
    const int tid = otid(); bf16_t* wq2 = (bf16_t*)(p.ws + WS_WQ2); float* G1 = (float*)(p.ws + WS_CTL + CTL_G1); float* B1 = (float*)(p.ws + WS_CTL + CTL_B1);
    for (int blk = blockIdx.x; blk < DM / 8; blk += gridDim.x) { f32x4 sg = (f32x4){0.f, 0.f, 0.f, 0.f}, sb = (f32x4){0.f, 0.f, 0.f, 0.f};
#pragma unroll
        for (int i = 0; i < 8; ++i) { const int k = blk * 8 + i; const float g = p.ln1_g[k], b = p.ln1_b[k]; const f32x4 w = *(const f32x4*)(p.wq + (size_t)k * DM + tid * 4);
            const f32x4 wg = w * g; sg += wg; sb += w * b;
            u32x2 o; o.x = cvt_pk_bf16(wg[0], wg[1]); o.y = cvt_pk_bf16(wg[2], wg[3]); *(u32x2*)(wq2 + (size_t)k * DM + tid * 4) = o; }
#pragma unroll
        for (int j = 0; j < 4; ++j) { atomicAdd(G1 + tid * 4 + j, sg[j]); atomicAdd(B1 + tid * 4 + j, sb[j]); } }
}
__device__ __forceinline__ void ph_gkbk(const Params& p, int rank) {
    const int tid = otid(), wid = tid >> 6, lane = tid & 63; const bf16_t* kx = (const bf16_t*)(p.ws + WS_KX); const float* G1 = (const float*)(p.ws + WS_CTL + CTL_G1); const float* B1 = (const float*)(p.ws + WS_CTL + CTL_B1);
    float* GK = (float*)(p.ws + WS_CTL + CTL_GK); float* BK = (float*)(p.ws + WS_CTL + CTL_BK);
#pragma unroll
    for (int i = 0; i < 2; ++i) { const int o = rank * 16 + wid * 2 + i, b = o >> 10, h = (o >> 8) & 3, m = o & 255;
        const u32x4 w = *(const u32x4*)(kx + (size_t)(b * 256 + m) * DM + h * 512 + lane * 8); float x[8]; unpack8(w, x);
        const f32x4 g0 = *(const f32x4*)(G1 + h * 512 + lane * 8), g1 = *(const f32x4*)(G1 + h * 512 + lane * 8 + 4), b0 = *(const f32x4*)(B1 + h * 512 + lane * 8), b1 = *(const f32x4*)(B1 + h * 512 + lane * 8 + 4);
        float sg = (x[0] * g0[0] + x[1] * g0[1]) + (x[2] * g0[2] + x[3] * g0[3]) + (x[4] * g1[0] + x[5] * g1[1]) + (x[6] * g1[2] + x[7] * g1[3]);
        float sb = (x[0] * b0[0] + x[1] * b0[1]) + (x[2] * b0[2] + x[3] * b0[3]) + (x[4] * b1[0] + x[5] * b1[1]) + (x[6] * b1[2] + x[7] * b1[3]);
        sg = wave_sum(sg); sb = wave_sum(sb);
        if (lane == 0) { GK[o] = sg; BK[o] = sb; } }
}

extern __shared__ __attribute__((aligned(16))) unsigned char dynlds[];
__device__ __forceinline__ void moe_tables(const Params& p, LAS unsigned char* xl) {
    LAS int* ct = (LAS int*)(xl + 8192); LAS int* cnt = (LAS int*)(xl + 8192 + 512);
    const int* counts = (const int*)(p.ws + WS_CTL + CTL_COUNTS);
    const int tid = otid();
    if (tid < NEXP) cnt[tid] = __hip_atomic_load(counts + tid, __ATOMIC_RELAXED, __HIP_MEMORY_SCOPE_AGENT);
    __syncthreads();
    if (tid == 0) { int s = 0; for (int e = 0; e < NEXP; ++e) { ct[e] = s; s += (cnt[e] + 255) >> 8; } ct[NEXP] = s;
        LAS int* tl = (LAS int*)(xl + 8192 + 1024) + 1; const int x = blockIdx.x & 7; int nt_ = 0;
        for (int pass = 0; pass < 2; ++pass) for (int k = 0; k < 8; ++k) { const int e = x + 8 * k, n = cnt[e], nt = (n + 255) >> 8, nl = (nt > 0 && (n - (nt - 1) * 256) <= 128) ? 1 : 0;
            if (pass == 0) { for (int j = 0; j < nt - nl; ++j) tl[nt_++] = e | (j << 8); } else if (nl) tl[nt_++] = e | ((nt - 1) << 8) | (1 << 16); }
        tl[-1] = nt_; }
    __syncthreads();
}
#ifndef DUP_MASK
#define DUP_MASK 0
#endif
#define DUP_N 1
template <int N, class F> __device__ __forceinline__ void repeat_n(const F& f) { if constexpr (N > 0) { f(); repeat_n<N - 1>(f); } }
#define PH(bit, ...) { __VA_ARGS__; xcd_barrier(bar); } if constexpr (((DUP_MASK) >> (bit)) & 1) { repeat_n<DUP_N>([&]() { __VA_ARGS__; xcd_barrier(bar); }); }
__global__ __launch_bounds__(NTHR, 2) void k_mega(Params p) {
    LAS unsigned char* lds = (LAS unsigned char*)dynlds; LAS unsigned char* xl = lds + XL_OFF;
    const int G = gridDim.x, c = blockIdx.x;
    volatile LAS unsigned* xbw = (volatile LAS unsigned*)(lds + LDS_BYTES - 16);
    if (threadIdx.x == 0) { xbw[0] = 0u; xbw[1] = 0u; xbw[2] = 0u; xbw[3] = 0u; }
    __syncthreads();
    const XcdBarrier bar = xcd_barrier_post((unsigned*)(p.ws + WS_CTL), xbw);
    if constexpr (((DUP_MASK) >> 15) & 1) { repeat_n<DUP_N>([&]() { ph_ln0(p, lds); __syncthreads(); }); }
    if constexpr (((DUP_MASK) >> 16) & 1) { repeat_n<DUP_N>([&]() { ph_wr_frag(p); ph_transpose(p, lds, 0, TR_SMALL, blockIdx.x, gridDim.x); }); }
    PH(0, ph_ln0(p, lds); __syncthreads(); ph_wr_frag(p); ph_grbr(p); ph_wq2(p); ph_transpose(p, lds, 0, TR_SMALL, blockIdx.x, gridDim.x))
    PH(1, { pg8::PlainSched S; S.init(p.ws + WS_REGA, p.ws + WS_WINT, T_TOK, NPROJ, DM, DM, G, c); pg8::EpiBf16 E{(bf16_t*)(p.ws + WS_REGB), NPROJ}; pg8::gemm_phase<pg8::EpiBf16, pg8::PlainSched, false>(lds, xl, DM, DM, DM, S, E); })
    PH(3, ph_gdn_prep(p, lds))
    PH(4, ph_gdn_passA(p, lds))
    PH(5, if (blockIdx.x < 16) { ph_gdn_combine(p, lds);
              { pg8::PlainSched S; S.init(p.ws + WS_MEMB, p.ws + WS_WKT, 512, DM, DM, DM, 16, c); pg8::EpiBf16 E{(bf16_t*)(p.ws + WS_KX), DM}; pg8::gemm_phase<pg8::EpiBf16, pg8::PlainSched, false>(lds, xl, DM, DM, DM, S, E); }
              { pg8::PlainSched S; S.init(p.ws + WS_MEMB, p.ws + WS_WVT, 512, DM, DM, DM, 16, c); pg8::EpiBf16 E{(bf16_t*)(p.ws + WS_VT), DM}; pg8::gemm_phase<pg8::EpiBf16, pg8::PlainSched, false>(lds, xl, DM, DM, DM, S, E); } }
          ph_transpose_experts(p, lds, xl))
    PH(6, ph_gdn_passB(p, lds))
    PH(7, { pg8::PlainSched S; S.init(p.ws + WS_REGC, p.ws + WS_WOUTT, T_TOK, DM, DM, DM, G, c); pg8::EpiResid1 E{(bf16_t*)(p.ws + WS_REGB), (const bf16_t*)(p.ws + WS_REGA), (float*)(p.ws + WS_PART1)};
            pg8::gemm_phase<pg8::EpiResid1, pg8::PlainSched, false>(lds, xl, DM, DM, DM, S, E); }
          { pg8::MNSched S{(const char*)(p.ws + WS_KX), (const char*)(p.ws + WS_VT), (const char*)(p.ws + WS_WQ2), (const char*)(p.ws + WS_WOT), c, 0}; pg8::EpiBf16 E{(bf16_t*)(p.ws + WS_MT), DM};
            pg8::gemm_phase<pg8::EpiBf16, pg8::MNSched, false>(lds, xl, DM, DM, 512, S, E); }
          { pg8::MNSched S{(const char*)(p.ws + WS_KX), (const char*)(p.ws + WS_VT), (const char*)(p.ws + WS_WQ2), (const char*)(p.ws + WS_WOT), c, 1}; pg8::EpiBf16 E{(bf16_t*)(p.ws + WS_NT), 1024};
            pg8::gemm_phase<pg8::EpiBf16, pg8::MNSched, false>(lds, xl, DM, DM, 512, S, E); }
          if (c >= 128) ph_gkbk(p, c - 128))
    PH(9, { pg8::AttnS2Sched S{(const char*)(p.ws + WS_REGB), (const char*)(p.ws + WS_MT), G, c};
            pg8::EpiSoftmax2 E{(bf16_t*)(p.ws + WS_REGC), 0.044194173824159216f * 1.4426950408889634f, (const float*)(p.ws + WS_PART1), (const float*)(p.ws + WS_CTL + CTL_GK), (const float*)(p.ws + WS_CTL + CTL_BK), (float*)(p.ws + WS_STATS1)};
            pg8::gemm_phase<pg8::EpiSoftmax2, pg8::AttnS2Sched, false>(lds, xl, DM, DM, DM, S, E); })
    PH(10, { pg8::AttnO2Sched S{(const char*)(p.ws + WS_REGC), (const char*)(p.ws + WS_NT), 1024, G, c}; pg8::EpiResid2 E{(bf16_t*)(p.ws + WS_S2), (const bf16_t*)(p.ws + WS_REGB), (const float*)(p.ws + WS_STATS1), (float*)(p.ws + WS_PART2), p.ln1_g, p.ln1_b};
             pg8::gemm_phase<pg8::EpiResid2, pg8::AttnO2Sched, false>(lds, xl, 1024, 1024, 1024, S, E); })
    { ph_ln2_router(p, lds); xcd_barrier(bar); }
    moe_tables(p, xl);
    PH(13, { pg8::MoeSched S{(const LAS int*)(xl + 8192), (const LAS int*)(xl + 8192 + 512), 4, G, c, 0, p.ws, (const LAS int*)(xl + 8192 + 1024) + 1};
             pg8::EpiSwiGLU E{(bf16_t*)(p.ws + WS_REGA), p.ws, (const LAS int*)(xl + 8192 + 512)}; pg8::gemm_phase<pg8::EpiSwiGLU, pg8::MoeSched, true, true>(lds, xl, DM, DM, DM, S, E); })
    PH(14, { pg8::MoeSched S{(const LAS int*)(xl + 8192), (const LAS int*)(xl + 8192 + 512), 8, G, c, 1, p.ws, (const LAS int*)(xl + 8192 + 1024) + 1};
             pg8::EpiScatter E{(bf16_t*)p.out, (const int*)(p.ws + WS_SLOT), (const LAS int*)(xl + 8192 + 512)}; pg8::gemm_phase<pg8::EpiScatter, pg8::MoeSched, false, true>(lds, xl, 512, 512, 512, S, E); })
    ph_ln3(p);
}

extern "C" void kernel_launch(void* const* d_in, const int* in_sizes, int n_in, void* d_out, int out_size, void* d_ws, size_t ws_size, hipStream_t stream) {
    static int grid = 0;
    if (grid == 0) {
        if (n_in != 26 || in_sizes[0] != T_TOK * DM || out_size != T_TOK * DM || ws_size < WS_END) {
            fprintf(stderr, "kernel_launch: unexpected shapes: n_in %d in0 %d out %d ws %zu (need %zu); nothing launched\n", n_in, n_in > 0 ? in_sizes[0] : -1, out_size, ws_size, (size_t)WS_END); grid = -1; return; }
        int dev = 0, cus = 0, per_cu = 0;
        if (hipGetDevice(&dev) != hipSuccess || hipDeviceGetAttribute(&cus, hipDeviceAttributeMultiprocessorCount, dev) != hipSuccess) { grid = -1; return; }
        if (hipFuncSetAttribute((const void*)k_mega, hipFuncAttributeMaxDynamicSharedMemorySize, LDS_BYTES) != hipSuccess) { fprintf(stderr, "kernel_launch: hipFuncSetAttribute failed\n"); grid = -1; return; }
        if (hipOccupancyMaxActiveBlocksPerMultiprocessor(&per_cu, (const void*)k_mega, NTHR, LDS_BYTES) != hipSuccess || per_cu < 1) fprintf(stderr, "kernel_launch: occupancy query says %d\n", per_cu);
        (void)hipGetLastError();
        grid = cus;
    }
    if (grid < 0) return;
    (void)hipMemsetAsync((char*)d_ws + WS_CTL, 0, CTL_BYTES, stream);
    Params p{};
    const float** pp = (const float**)&p;
    for (int i = 0; i < 26; ++i) pp[i] = (const float*)d_in[i];
    p.out = (float*)d_out; p.ws = (unsigned char*)d_ws;
    hipLaunchKernelGGL(k_mega, dim3(grid), dim3(NTHR), LDS_BYTES, stream, p);
}
```
